# Optimizing an MI355X kernel written in HIP

```python
import jax, jax.numpy as jnp
from jax import lax
import numpy as np

D_MODEL = 1024
BATCH = 4
SEQ = 4096
DEPTH = 2
DEC_BATCH = 128
DEC_SEQ = 8
PAST_LEN = 2048
PAGE_SIZE = 128

HEAD_DIM = 64
A_GROUPS = ((128, 1), (512, 4), (2048, 16))
A_HPG = 4
A_HEADS = A_HPG * len(A_GROUPS)
A_WIDTH = A_HEADS * HEAD_DIM
A_OUT = A_HPG * HEAD_DIM
B_WIDTH = D_MODEL // 2
B_CONV = 3
C_WIDTH = D_MODEL // 2
C_CHUNK = 128
C_GROUPS = 4
C_GDIM = C_WIDTH // C_GROUPS
D_WIDTH = D_MODEL // 2
D_CONV = 31
D_FF = 2816
N_BRANCH = 4
IN_SPLITS = (A_WIDTH, A_WIDTH, A_WIDTH, B_WIDTH, B_WIDTH, B_WIDTH, C_WIDTH, C_WIDTH, 2 * D_WIDTH, N_BRANCH * D_MODEL)
IN_COLS = sum(IN_SPLITS)
EPS = 1e-6

kernel_name = "hybrid_dilated_attn_conv_gmlp_step"


def _rmsnorm(x, g):
    xf = x.astype(jnp.float32)
    y = xf * lax.rsqrt(jnp.mean(xf * xf, axis=-1, keepdims=True) + EPS)
    return (y * g.astype(jnp.float32)).astype(x.dtype)


def _layernorm(x, g, b):
    xf = x.astype(jnp.float32)
    mu = jnp.mean(xf, axis=-1, keepdims=True)
    xc = xf - mu
    var = jnp.mean(xc * xc, axis=-1, keepdims=True)
    return (xc * lax.rsqrt(var + EPS) * g.astype(jnp.float32) + b.astype(jnp.float32)).astype(x.dtype)


def _swiglu(x, wg, wu, wd):
    return (jax.nn.silu(x @ wg) * (x @ wu)) @ wd


def _half_ffn(x, pre_g, post_g, wg, wu, wd):
    return x + 0.5 * _rmsnorm(_swiglu(_rmsnorm(x, pre_g), wg, wu, wd), post_g)


def _alibi_slopes():
    return jnp.exp2(-8.0 * jnp.arange(1, A_HEADS + 1, dtype=jnp.float32) / A_HEADS)


def _dwconv(xpad, w):
    c = xpad.shape[-1]
    return lax.conv_general_dilated(xpad, w[:, None, :], window_strides=(1,), padding='VALID',
                                    dimension_numbers=('NWC', 'WIO', 'NWC'), feature_group_count=c)


def _softmax_with_lse(s):
    m = jnp.max(s, axis=-1, keepdims=True)
    p = jnp.exp(s - m)
    den = jnp.sum(p, axis=-1, keepdims=True)
    return p / den, (m + jnp.log(den))[..., 0]


def _dilated_prompt(q, k, v, window, dil, slopes):
    n, s_len, h, dh = q.shape
    nk = window // dil
    ln = s_len // dil
    nblk = -(-ln // nk)
    lp = nblk * nk

    def to_blocks(t):
        t = t.reshape(n, ln, dil, h, dh).transpose(0, 2, 1, 3, 4)
        t = jnp.pad(t, ((0, 0), (0, 0), (0, lp - ln), (0, 0), (0, 0)))
        return t.reshape(n, dil, nblk, nk, h, dh)

    def with_prev(t):
        prev = jnp.pad(t, ((0, 0), (0, 0), (1, 0), (0, 0), (0, 0), (0, 0)))[:, :, :-1]
        return jnp.concatenate([prev, t], axis=3)

    qb = to_blocks(q)
    kk = with_prev(to_blocks(k))
    vv = with_prev(to_blocks(v))
    s = jnp.einsum('brnqhd,brnkhd->brnhqk', qb, kk).astype(jnp.float32) * (dh ** -0.5)
    rel = nk + jnp.arange(nk)[:, None] - jnp.arange(2 * nk)[None, :]
    kidx = jnp.arange(nblk)[:, None] * nk - nk + jnp.arange(2 * nk)[None, :]
    valid = ((rel >= 0) & (rel <= nk))[None] & (kidx >= 0)[:, None, :]
    bias = -slopes[:, None, None] * (dil * rel).astype(jnp.float32)
    s = jnp.where(valid[:, None], s + bias, -jnp.inf)
    p, lse = _softmax_with_lse(s)
    o = jnp.einsum('brnhqk,brnkhd->brnqhd', p, vv.astype(jnp.float32))
    o = o.reshape(n, dil, lp, h, dh)[:, :, :ln].transpose(0, 2, 1, 3, 4).reshape(n, s_len, h, dh)
    lse = lse.transpose(0, 1, 2, 4, 3).reshape(n, dil, lp, h)[:, :, :ln].transpose(0, 2, 1, 3).reshape(n, s_len, h)
    return o, lse


def _dilated_sample(q, k_new, v_new, k_buf, v_buf, window, dil, slopes):
    n, t_len, h, dh = q.shape
    nk = window // dil
    lw = k_buf.shape[1]
    kk = jnp.concatenate([k_buf, k_new], axis=1)
    vv = jnp.concatenate([v_buf, v_new], axis=1)
    steps = jnp.arange(nk + 1)
    idx = lw + jnp.arange(t_len)[:, None] - dil * steps[None, :]
    valid = idx >= 0
    idx = jnp.maximum(idx, 0)
    kg = kk[:, idx]
    vg = vv[:, idx]
    s = jnp.einsum('bthd,btkhd->bhtk', q, kg).astype(jnp.float32) * (dh ** -0.5)
    bias = -slopes[:, None, None] * (dil * steps).astype(jnp.float32)[None, None, :]
    s = jnp.where(valid[None, None], s + bias, -jnp.inf)
    p, lse = _softmax_with_lse(s)
    o = jnp.einsum('bhtk,btkhd->bthd', p, vg.astype(jnp.float32))
    return o, lse.transpose(0, 2, 1)


def _mixer(h, W, l, st, prompt):
    n, t_len, _ = h.shape
    cuts = [int(c) for c in np.cumsum(IN_SPLITS)[:-1]]
    z = h @ W['w_in'][l]
    q, k, v, b_gate, c_gate, b_in, u, gv, glu_in, gates = jnp.split(z, cuts, axis=-1)

    q = q.reshape(n, t_len, A_HEADS, HEAD_DIM)
    k = k.reshape(n, t_len, A_HEADS, HEAD_DIM)
    v = v.reshape(n, t_len, A_HEADS, HEAD_DIM)
    slopes = _alibi_slopes()
    outs, lses, new_attn = [], [], []
    for g, (win, dil) in enumerate(A_GROUPS):
        hs = slice(g * A_HPG, (g + 1) * A_HPG)
        qg, kg, vg = q[:, :, hs], k[:, :, hs], v[:, :, hs]
        if prompt:
            o, lse = _dilated_prompt(qg, kg, vg, win, dil, slopes[hs])
            keep = min(win, t_len)
            new_attn.append(jnp.stack([kg[:, t_len - keep:], vg[:, t_len - keep:]], axis=2))
        else:
            buf = st[0][g]
            o, lse = _dilated_sample(qg, kg, vg, buf[:, :, 0], buf[:, :, 1], win, dil, slopes[hs])
            new_attn.append(jnp.stack([kg, vg], axis=2))
        outs.append(o)
        lses.append(lse)
    wts = jax.nn.softmax(jnp.stack(lses, axis=0), axis=0)
    attn = jnp.sum(wts[..., None] * jnp.stack(outs, axis=0), axis=0)
    br_a = attn.reshape(n, t_len, A_OUT).astype(h.dtype) @ W['w_out_a'][l]

    zc = c_gate * b_in
    prev_b = jnp.zeros((n, B_CONV - 1, B_WIDTH), h.dtype) if prompt else st[1]
    zpad = jnp.concatenate([prev_b, zc], axis=1)
    br_b = (b_gate * _dwconv(zpad, W['conv_b_w'][l])) @ W['w_out_b'][l]
    new_b = zpad[:, -(B_CONV - 1):]

    vn = _layernorm(gv, W['gmlp_ln_g'][l], W['gmlp_ln_b'][l])
    ws = jnp.where(jnp.tril(jnp.ones((C_CHUNK, C_CHUNK), dtype=bool)), W['gmlp_ws'][l], 0)
    if prompt:
        vr = vn.reshape(n, t_len // C_CHUNK, C_CHUNK, C_GROUPS, C_GDIM)
        mixed = jnp.einsum('gts,bnsgc->bntgc', ws, vr) + W['gmlp_b'][l].T[None, None, :, :, None]
    else:
        vr = vn.reshape(n, t_len, C_GROUPS, C_GDIM)
        mixed = jnp.einsum('gts,bsgc->btgc', ws[:, :t_len, :t_len], vr) + W['gmlp_b'][l][:, :t_len].T[None, :, :, None]
    br_c = (u * mixed.reshape(n, t_len, C_WIDTH)) @ W['w_out_c'][l]

    a_half, g_half = jnp.split(glu_in, 2, axis=-1)
    glu = a_half * jax.nn.sigmoid(g_half)
    prev_d = jnp.zeros((n, D_CONV - 1, D_WIDTH), h.dtype) if prompt else st[2]
    gpad = jnp.concatenate([prev_d, glu], axis=1)
    dc = _dwconv(gpad, W['conv_d_w'][l]) + W['conv_d_b'][l]
    br_d = jax.nn.silu(_layernorm(dc, W['conv_d_ln_g'][l], W['conv_d_ln_b'][l])) @ W['w_out_d'][l]
    new_d = gpad[:, -(D_CONV - 1):]

    gs = jax.nn.sigmoid(gates).reshape(n, t_len, N_BRANCH, D_MODEL)
    merged = gs[:, :, 0] * br_a + gs[:, :, 1] * br_b + gs[:, :, 2] * br_c + gs[:, :, 3] * br_d
    y = merged @ W['w_o'][l]
    return y, new_attn, new_b, vn, new_d


def _layer(x, W, l, st, prompt):
    x = _half_ffn(x, W['ffn1_pre_g'][l], W['ffn1_post_g'][l], W['ffn1_w_gate'][l], W['ffn1_w_up'][l], W['ffn1_w_down'][l])
    y, new_attn, new_b, vn, new_d = _mixer(_rmsnorm(x, W['mix_pre_g'][l]), W, l, st, prompt)
    x = x + _rmsnorm(y, W['mix_post_g'][l])
    x = _half_ffn(x, W['ffn2_pre_g'][l], W['ffn2_post_g'][l], W['ffn2_w_gate'][l], W['ffn2_w_up'][l], W['ffn2_w_down'][l])
    return x, new_attn, new_b, vn, new_d


def setup_inputs(seed: int = 0) -> dict:
    key = jax.random.key(seed)
    keys = list(jax.random.split(key, 64))

    def nrm(shape, scale):
        return jax.random.normal(keys.pop(), shape, jnp.float32) * scale

    def gain(width):
        return 1.0 + nrm((DEPTH, width), 0.02)

    inp = {}
    inp['x_prompt'] = nrm((BATCH, SEQ, D_MODEL), 1.0)
    inp['x_sample'] = nrm((DEC_BATCH, DEC_SEQ, D_MODEL), 1.0)
    for win, _ in A_GROUPS:
        inp['cache_attn_w' + str(win)] = nrm((DEPTH, DEC_BATCH, min(win, PAST_LEN), 2, A_HPG, HEAD_DIM), 1.0)
    inp['state_conv_b'] = nrm((DEPTH, DEC_BATCH, B_CONV - 1, B_WIDTH), 1.0)
    inp['state_conv_d'] = nrm((DEPTH, DEC_BATCH, D_CONV - 1, D_WIDTH), 0.5)
    inp['ffn1_pre_g'] = gain(D_MODEL)
    inp['ffn1_post_g'] = gain(D_MODEL)
    inp['ffn1_w_gate'] = nrm((DEPTH, D_MODEL, D_FF), D_MODEL ** -0.5)
    inp['ffn1_w_up'] = nrm((DEPTH, D_MODEL, D_FF), D_MODEL ** -0.5)
    inp['ffn1_w_down'] = nrm((DEPTH, D_FF, D_MODEL), D_FF ** -0.5)
    inp['mix_pre_g'] = gain(D_MODEL)
    inp['mix_post_g'] = gain(D_MODEL)
    inp['w_in'] = nrm((DEPTH, D_MODEL, IN_COLS), D_MODEL ** -0.5)
    inp['w_out_a'] = nrm((DEPTH, A_OUT, D_MODEL), A_OUT ** -0.5)
    inp['conv_b_w'] = nrm((DEPTH, B_CONV, B_WIDTH), B_CONV ** -0.5)
    inp['w_out_b'] = nrm((DEPTH, B_WIDTH, D_MODEL), B_WIDTH ** -0.5)
    inp['gmlp_ln_g'] = gain(C_WIDTH)
    inp['gmlp_ln_b'] = nrm((DEPTH, C_WIDTH), 0.02)
    inp['gmlp_ws'] = nrm((DEPTH, C_GROUPS, C_CHUNK, C_CHUNK), C_CHUNK ** -0.5)
    inp['gmlp_b'] = 1.0 + nrm((DEPTH, C_GROUPS, C_CHUNK), 0.05)
    inp['w_out_c'] = nrm((DEPTH, C_WIDTH, D_MODEL), C_WIDTH ** -0.5)
    inp['conv_d_w'] = nrm((DEPTH, D_CONV, D_WIDTH), D_CONV ** -0.5)
    inp['conv_d_b'] = nrm((DEPTH, D_WIDTH), 0.02)
    inp['conv_d_ln_g'] = gain(D_WIDTH)
    inp['conv_d_ln_b'] = nrm((DEPTH, D_WIDTH), 0.02)
    inp['w_out_d'] = nrm((DEPTH, D_WIDTH, D_MODEL), D_WIDTH ** -0.5)
    inp['w_o'] = nrm((DEPTH, D_MODEL, D_MODEL), D_MODEL ** -0.5)
    inp['ffn2_pre_g'] = gain(D_MODEL)
    inp['ffn2_post_g'] = gain(D_MODEL)
    inp['ffn2_w_gate'] = nrm((DEPTH, D_MODEL, D_FF), D_MODEL ** -0.5)
    inp['ffn2_w_up'] = nrm((DEPTH, D_MODEL, D_FF), D_MODEL ** -0.5)
    inp['ffn2_w_down'] = nrm((DEPTH, D_FF, D_MODEL), D_FF ** -0.5)
    return inp


def reference(x_prompt, x_sample, cache_attn_w128, cache_attn_w512, cache_attn_w2048, state_conv_b, state_conv_d,
              ffn1_pre_g, ffn1_post_g, ffn1_w_gate, ffn1_w_up, ffn1_w_down, mix_pre_g, mix_post_g, w_in,
              w_out_a, conv_b_w, w_out_b, gmlp_ln_g, gmlp_ln_b, gmlp_ws, gmlp_b, w_out_c, conv_d_w, conv_d_b,
              conv_d_ln_g, conv_d_ln_b, w_out_d, w_o, ffn2_pre_g, ffn2_post_g, ffn2_w_gate, ffn2_w_up, ffn2_w_down):
    W = dict(ffn1_pre_g=ffn1_pre_g, ffn1_post_g=ffn1_post_g, ffn1_w_gate=ffn1_w_gate, ffn1_w_up=ffn1_w_up,
             ffn1_w_down=ffn1_w_down, mix_pre_g=mix_pre_g, mix_post_g=mix_post_g, w_in=w_in, w_out_a=w_out_a,
             conv_b_w=conv_b_w, w_out_b=w_out_b, gmlp_ln_g=gmlp_ln_g, gmlp_ln_b=gmlp_ln_b, gmlp_ws=gmlp_ws,
             gmlp_b=gmlp_b, w_out_c=w_out_c, conv_d_w=conv_d_w, conv_d_b=conv_d_b, conv_d_ln_g=conv_d_ln_g,
             conv_d_ln_b=conv_d_ln_b, w_out_d=w_out_d, w_o=w_o, ffn2_pre_g=ffn2_pre_g, ffn2_post_g=ffn2_post_g,
             ffn2_w_gate=ffn2_w_gate, ffn2_w_up=ffn2_w_up, ffn2_w_down=ffn2_w_down)
    attn_caches = (cache_attn_w128, cache_attn_w512, cache_attn_w2048)
    yp, ys = x_prompt, x_sample
    pa = [[] for _ in A_GROUPS]
    sa = [[] for _ in A_GROUPS]
    pb, sb, sc, pd, sd = [], [], [], [], []
    for l in range(DEPTH):
        yp, na, nb, _, nd = _layer(yp, W, l, None, True)
        for g in range(len(A_GROUPS)):
            pa[g].append(na[g])
        pb.append(nb)
        pd.append(nd)
        st = ([c[l] for c in attn_caches], state_conv_b[l], state_conv_d[l])
        ys, na, nb, vn, nd = _layer(ys, W, l, st, False)
        for g in range(len(A_GROUPS)):
            sa[g].append(na[g])
        sb.append(nb)
        sc.append(vn)
        sd.append(nd)
    new_attn_w128_prompt = jnp.stack(pa[0], axis=0)
    new_attn_w512_prompt = jnp.stack(pa[1], axis=0)
    new_attn_w2048_prompt = jnp.stack(pa[2], axis=0)
    new_attn_w128_sample = jnp.stack(sa[0], axis=0)
    new_attn_w512_sample = jnp.stack(sa[1], axis=0)
    new_attn_w2048_sample = jnp.stack(sa[2], axis=0)
    new_conv_b_prompt = jnp.stack(pb, axis=0)
    new_conv_b_sample = jnp.stack(sb, axis=0)
    new_gmlp_v_sample = jnp.stack(sc, axis=0)
    new_conv_d_prompt = jnp.stack(pd, axis=0)
    new_conv_d_sample = jnp.stack(sd, axis=0)
    return (yp, ys, new_attn_w128_prompt, new_attn_w512_prompt, new_attn_w2048_prompt,
            new_attn_w128_sample, new_attn_w512_sample, new_attn_w2048_sample,
            new_conv_b_prompt, new_conv_b_sample, new_gmlp_v_sample, new_conv_d_prompt, new_conv_d_sample)
```

```cpp
#include <hip/hip_runtime.h>
#include <cstdio>
#include <cstdint>

#ifndef MK_N_LAUNCHES
#define MK_N_LAUNCHES 1
#endif

#define GAS __attribute__((address_space(1)))
#define LAS __attribute__((address_space(3)))
typedef unsigned short bf16;
typedef unsigned v4u __attribute__((ext_vector_type(4)));
typedef unsigned v2u __attribute__((ext_vector_type(2)));
typedef float f32x4 __attribute__((ext_vector_type(4)));
typedef float f32x2 __attribute__((ext_vector_type(2)));
typedef short bf16x8 __attribute__((ext_vector_type(8)));
typedef short s16x4 __attribute__((ext_vector_type(4)));
typedef GAS unsigned gu32;

constexpr int TP = 16384, TS = 1024, T = TP + TS, DM = 1024, FF = 2816, ZP = 9984, BRP = 1792, SEQ = 4096, NSEQ = 128, DSEQ = 8;
constexpr int ZQ = 0, ZK = 768, ZV = 1536, ZBG = 2304, ZCG = 2816, ZBI = 3328, ZU = 3840, ZGV = 4352, ZGA = 4864, ZGG = 5376, ZGT = 5888;
constexpr int BR_A = 0, BR_B = 256, BR_C = 768, BR_D = 1280;
constexpr float EPS = 1e-6f, LOG2E = 1.4426950408889634f, LN2 = 0.6931471805599453f;
constexpr size_t O_YP = 0, O_YS = 16777216, O_A128P = 17825792, O_A512P = 18350080, O_A2048P = 20447232, O_A128S = 28835840, O_A512S = 29884416,
                 O_A2048S = 30932992, O_CBP = 31981568, O_CBS = 31989760, O_GVS = 32251904, O_CDP = 33300480, O_CDS = 33423360, O_END = 37355520;
enum { I_XP = 0, I_XS, I_C128, I_C512, I_C2048, I_SB, I_SD, I_F1PRE, I_F1POST, I_F1G, I_F1U, I_F1D, I_MPRE, I_MPOST, I_WIN, I_WOA, I_CBW, I_WOB, I_GLG, I_GLB,
       I_GWS, I_GB, I_WOC, I_CDW, I_CDB, I_CDLG, I_CDLB, I_WOD, I_WO, I_F2PRE, I_F2POST, I_F2G, I_F2U, I_F2D, N_IN };
constexpr size_t MiB = 1u << 20;
constexpr size_t WS_CTL = 0, CTL_ZERO_BYTES = 1 * MiB;
constexpr size_t WS_W = 2 * MiB, W_LSTRIDE = 64 * MiB, W_GU1 = 0, W_D1 = 12 * MiB, W_IN = 18 * MiB, W_OUT = 38 * MiB, W_O = 42 * MiB, W_GU2 = 44 * MiB, W_D2 = 56 * MiB;
constexpr size_t WS_XN = 130 * MiB, WS_ACT = 164 * MiB, WS_F = 258 * MiB, WS_Z = 326 * MiB, WS_OP = 658 * MiB, WS_LSE = 682 * MiB, WS_BR = 683 * MiB,
                 WS_MG32 = 743 * MiB, WS_MG = 811 * MiB, WS_END = 845 * MiB;
constexpr int CW_TMO = 0, CW_BAR = 4096;
constexpr int LDS_BYTES = 147456, MISC_OFF = LDS_BYTES - 256;
constexpr int NWAVES = 8, NTHR = 512;
constexpr int NPHASE = 25;

#define LDS_WAIT() asm volatile("s_waitcnt lgkmcnt(0)" ::: "memory")
#define VM_WAIT() asm volatile("s_waitcnt vmcnt(0)" ::: "memory")
#define RLX_AGENT __ATOMIC_RELAXED, __HIP_MEMORY_SCOPE_AGENT
__device__ __forceinline__ unsigned cvt_pk_bf16(float lo, float hi) { unsigned r; asm volatile("v_cvt_pk_bf16_f32 %0, %1, %2" : "=v"(r) : "v"(lo), "v"(hi)); return r; }
__device__ __forceinline__ float bf_lo(unsigned w) { return __uint_as_float(w << 16); }
__device__ __forceinline__ float bf_hi(unsigned w) { return __uint_as_float(w & 0xffff0000u); }
__device__ __forceinline__ float bf1(bf16 h) { return __uint_as_float((unsigned)h << 16); }
__device__ __forceinline__ float fexp2(float x) { return __builtin_amdgcn_exp2f(x); }
__device__ __forceinline__ float frcp(float x) { return __builtin_amdgcn_rcpf(x); }
__device__ __forceinline__ float sigmoidf_(float x) { return frcp(1.0f + fexp2(-LOG2E * x)); }
__device__ __forceinline__ float wave_sum(float v) {
#pragma unroll
    for (int o = 1; o < 64; o <<= 1) v += __shfl_xor(v, o);
    return v;
}
__device__ __forceinline__ void unpack8(const v4u w, float (&f)[8]) {
    f[0] = bf_lo(w.x); f[1] = bf_hi(w.x); f[2] = bf_lo(w.y); f[3] = bf_hi(w.y); f[4] = bf_lo(w.z); f[5] = bf_hi(w.z); f[6] = bf_lo(w.w); f[7] = bf_hi(w.w);
}
__device__ __forceinline__ v4u pack8(const float (&f)[8]) { v4u w; w.x = cvt_pk_bf16(f[0], f[1]); w.y = cvt_pk_bf16(f[2], f[3]); w.z = cvt_pk_bf16(f[4], f[5]); w.w = cvt_pk_bf16(f[6], f[7]); return w; }

namespace pg8 {
typedef unsigned short bf16_t;
typedef unsigned u32x4 __attribute__((ext_vector_type(4)));
constexpr int BM = 256, BK = 64, HALF = 128, HTB = HALF * BK * 2, STAGE_BYTES = 8 * HTB, NXCD = 8, WGM = 8;
__host__ __device__ __forceinline__ int lds_byte(int r, int c) { const int st = (r >> 4) * 2 + (c >> 5), rr = r & 15, cc = c & 31, ob = rr * 64 + cc * 2; return st * 1024 + (ob ^ (((ob >> 9) & 1) << 5)); }
__host__ __device__ __forceinline__ void stage_rc(int b, int& R, int& C) { const int st = b / 1024, sb = b % 1024, swz = sb ^ (((sb >> 9) & 1) << 5); R = (st >> 1) * 16 + swz / 64; C = (st & 1) * 32 + (swz % 64) / 2; }
__host__ __device__ __forceinline__ int perm32(int rho) { const int n = rho >> 4, i = rho & 15; return 8 * (i >> 2) + 4 * n + (i & 3); }
struct Unit { int pm, pn; };
template <int K_, int LDA_, int LDB_> struct Gemm { const bf16_t* A; const bf16_t* Bt; static constexpr int K = K_, lda = LDA_, ldb = LDB_; };
template <int M_, int N_> struct StaticOrder {
    static constexpr int nM = M_ / BM, nN = N_ / BM, nwg = nM * nN; int G, c;
    __host__ __device__ void init(int G_, int c_) { G = G_; c = c_; }
    __host__ __device__ bool next(int i, Unit& u) const {
        const long L = (long)i * G + c; if (L >= nwg) return false;
        int wgid = (int)L; { const int q = nwg / NXCD, r = nwg % NXCD, xcd = wgid % NXCD, off = wgid / NXCD; wgid = (xcd < r ? xcd * (q + 1) : r * (q + 1) + (xcd - r) * q) + off; }
        const int nig = WGM * nN, gid = wgid / nig, fm = gid * WGM, gsz = (nM - fm) < WGM ? (nM - fm) : WGM;
        u.pm = fm + ((wgid % nig) % gsz); u.pn = (wgid % nig) / gsz; return true;
    }
};
struct EpiSwiGLU {
    static constexpr bool PERM = true;
    bf16_t* O; int ldc;
    __device__ __forceinline__ void operator()(const f32x4 (&acc)[2][2][4][2], const Unit& u, int wr, int wc, int fr, int fq) const {
        const int row0 = u.pm * BM + wr * 64 + fr, col0 = u.pn * HALF + wc * 32 + 8 * fq;
#pragma unroll
        for (int ai = 0; ai < 2; ++ai)
#pragma unroll
            for (int m = 0; m < 4; ++m) {
                float o[8];
#pragma unroll
                for (int n = 0; n < 2; ++n)
#pragma unroll
                    for (int e = 0; e < 4; ++e) { const float g = acc[ai][0][m][n][e], up = acc[ai][1][m][n][e]; o[4 * n + e] = g * up * frcp(1.0f + fexp2(-LOG2E * g)); }
                *(u32x4*)(O + (size_t)(row0 + ai * HALF + m * 16) * ldc + col0) = pack8(o);
            }
    }
};
struct EpiZ {
    static constexpr bool PERM = true;
    bf16_t* O; int ldc; int sig_from;
    __device__ __forceinline__ void operator()(const f32x4 (&acc)[2][2][4][2], const Unit& u, int wr, int wc, int fr, int fq) const {
        const int row0 = u.pm * BM + wr * 64 + fr, col0 = u.pn * BM + wc * 32 + 8 * fq;
        const bool sg = u.pn >= sig_from;
#pragma unroll
        for (int ai = 0; ai < 2; ++ai)
#pragma unroll
            for (int m = 0; m < 4; ++m)
#pragma unroll
                for (int bj = 0; bj < 2; ++bj) {
                    float o[8];
#pragma unroll
                    for (int n = 0; n < 2; ++n)
#pragma unroll
                        for (int e = 0; e < 4; ++e) { const float v = acc[ai][bj][m][n][e]; o[4 * n + e] = v; }
                    if (sg) {
#pragma unroll
                        for (int e = 0; e < 8; ++e) o[e] = frcp(1.0f + fexp2(-LOG2E * o[e]));
                    }
                    *(u32x4*)(O + (size_t)(row0 + ai * HALF + m * 16) * ldc + col0 + bj * HALF) = pack8(o);
                }
    }
};
struct EpiF32 {
    static constexpr bool PERM = false;
    float* O; int ldc;
    __device__ __forceinline__ void operator()(const f32x4 (&acc)[2][2][4][2], const Unit& u, int wr, int wc, int fr, int fq) const {
        const int row0 = u.pm * BM + wr * 64 + fr, col0 = u.pn * BM + wc * 32 + 4 * fq;
#pragma unroll
        for (int ai = 0; ai < 2; ++ai)
#pragma unroll
            for (int m = 0; m < 4; ++m)
#pragma unroll
                for (int bj = 0; bj < 2; ++bj)
#pragma unroll
                    for (int n = 0; n < 2; ++n) *(f32x4*)(O + (size_t)(row0 + ai * HALF + m * 16) * ldc + col0 + bj * HALF + n * 16) = acc[ai][bj][m][n];
    }
};
template <int MODE> struct EpiGate {
    static constexpr bool PERM = false;
    float* S; bf16_t* OB; const bf16_t* sg; int ldg;
    __device__ __forceinline__ void operator()(const f32x4 (&acc)[2][2][4][2], const Unit& u, int wr, int wc, int fr, int fq) const {
        const int row0 = u.pm * BM + wr * 64 + fr, col0 = u.pn * BM + wc * 32 + 4 * fq;
#pragma unroll
        for (int ai = 0; ai < 2; ++ai)
#pragma unroll
            for (int m = 0; m < 4; ++m)
#pragma unroll
                for (int bj = 0; bj < 2; ++bj)
#pragma unroll
                    for (int n = 0; n < 2; ++n) {
                        const size_t r = (size_t)(row0 + ai * HALF + m * 16); const int c = col0 + bj * HALF + n * 16;
                        const v2u gw = *(const v2u*)(sg + r * ldg + c);
                        f32x4 v = acc[ai][bj][m][n]; v[0] *= bf_lo(gw.x); v[1] *= bf_hi(gw.x); v[2] *= bf_lo(gw.y); v[3] *= bf_hi(gw.y);
                        if (MODE != 0) v += *(const f32x4*)(S + r * DM + c);
                        if (MODE != 2) *(f32x4*)(S + r * DM + c) = v;
                        else { v2u w; w.x = cvt_pk_bf16(v[0], v[1]); w.y = cvt_pk_bf16(v[2], v[3]); *(v2u*)(OB + r * DM + c) = w; }
                    }
    }
};

template <class Epi, class Sched, class GemmT>
__device__ __forceinline__ void gemm_phase(LAS unsigned char* lds, const GemmT g, const Sched& S, const Epi& E, int tid_in) {
    const int tid = tid_in, wid = __builtin_amdgcn_readfirstlane(tid >> 6), lane = tid & 63, wr = wid >> 2, wc = wid & 3, fr = lane & 15, fq = lane >> 4;
    constexpr int K = GemmT::K, nt = K / BK;
    unsigned voffA[2], voffB[2];
#pragma unroll
    for (int i = 0; i < 2; ++i) { int R, C; stage_rc(tid * 16 + i * 8192, R, C); const int Rb = Epi::PERM ? ((R & ~31) + perm32(R & 31)) : R;
        voffA[i] = (unsigned)(R * GemmT::lda + C) * 2u; voffB[i] = (unsigned)(Rb * GemmT::ldb + C) * 2u; }
    constexpr size_t kstep = (size_t)(BK * 2);
    constexpr size_t hA = (size_t)HALF * GemmT::lda * 2, hB = (size_t)HALF * GemmT::ldb * 2;
    constexpr size_t tA = 2 * hA, tB = 2 * hB;
    const unsigned ldsw = (unsigned)wid * 1024u;
    const int aoff = lds_byte(wr * 64 + fr, fq * 8), boff = lds_byte(wc * 32 + fr, fq * 8);
#define PG8_SA(b, h) (((b) * 2 + (h)) * HTB)
#define PG8_SB(b, h) ((4 + (b) * 2 + (h)) * HTB)
#define PG8_STAGE(bufoff, gbase, voff) do { _Pragma("unroll") for (int _i = 0; _i < 2; ++_i) \
        __builtin_amdgcn_global_load_lds((const unsigned*)((const char*)(gbase) + (voff)[_i]), (LAS unsigned*)(lds + (bufoff) + ldsw + _i * 8192), 16, 0, 0); } while (0)
#define PG8_LDA(dst, b, h) do { _Pragma("unroll") for (int m = 0; m < 4; ++m) _Pragma("unroll") for (int k = 0; k < 2; ++k) dst[m][k] = *(const LAS bf16x8*)(lds + PG8_SA(b, h) + aoff + m * 2048 + k * 1024); } while (0)
#define PG8_LDB(dst, b, h) do { _Pragma("unroll") for (int n = 0; n < 2; ++n) _Pragma("unroll") for (int k = 0; k < 2; ++k) dst[n][k] = *(const LAS bf16x8*)(lds + PG8_SB(b, h) + boff + n * 2048 + k * 1024); } while (0)
#define PG8_MMA(ai, bj, At, Bt) do { __builtin_amdgcn_s_setprio(1); _Pragma("unroll") for (int m = 0; m < 4; ++m) _Pragma("unroll") for (int n = 0; n < 2; ++n) _Pragma("unroll") for (int k = 0; k < 2; ++k) \
        acc[ai][bj][m][n] = __builtin_amdgcn_mfma_f32_16x16x32_bf16(Bt[n][k], At[m][k], acc[ai][bj][m][n], 0, 0, 0); __builtin_amdgcn_s_setprio(0); } while (0)
#define PG8_WAIT_V(n) asm volatile("s_waitcnt vmcnt(" #n ")" ::: "memory")
#define PG8_WAIT_L(n) asm volatile("s_waitcnt lgkmcnt(" #n ")" ::: "memory")
#define PG8_BAR __builtin_amdgcn_s_barrier()
#define PG8_SCHED __builtin_amdgcn_sched_barrier(0)
    Unit cur, nxt; int ui = 0;
    if (!S.next(0, cur)) return;
    f32x4 acc[2][2][4][2];
#pragma unroll
    for (int a = 0; a < 2; ++a)
#pragma unroll
        for (int b = 0; b < 2; ++b)
#pragma unroll
            for (int m = 0; m < 4; ++m)
#pragma unroll
                for (int n = 0; n < 2; ++n) acc[a][b][m][n] = (f32x4){0.f, 0.f, 0.f, 0.f};
    bf16x8 At[4][2], B0[2][2], B1[2][2];
    const char* cA = (const char*)g.A + (size_t)cur.pm * tA; const char* cB = (const char*)g.Bt + (size_t)cur.pn * tB;
    PG8_STAGE(PG8_SB(0, 0), cB, voffB); PG8_STAGE(PG8_SB(0, 1), cB + hB, voffB); PG8_STAGE(PG8_SA(0, 0), cA, voffA); PG8_STAGE(PG8_SA(0, 1), cA + hA, voffA);
    if (wr == 1) PG8_BAR;
    PG8_WAIT_V(2); PG8_BAR;
    PG8_STAGE(PG8_SB(1, 0), cB + kstep, voffB); PG8_STAGE(PG8_SA(1, 0), cA + kstep, voffA); PG8_STAGE(PG8_SB(1, 1), cB + hB + kstep, voffB);
    PG8_WAIT_V(6); PG8_BAR;
    for (;;) {
        const bool has_next = S.next(ui + 1, nxt);
        const char* nA = has_next ? (const char*)g.A + (size_t)nxt.pm * tA : cA; const char* nB = has_next ? (const char*)g.Bt + (size_t)nxt.pn * tB : cB;
        for (int t = 0; t < nt; t += 2) {
            const bool last = (t == nt - 2);
            const char* a1 = cA + (size_t)(t + 1) * kstep;
            const char* a2 = last ? nA : cA + (size_t)(t + 2) * kstep; const char* b2 = last ? nB : cB + (size_t)(t + 2) * kstep;
            const char* a3 = a2 + kstep; const char* b3 = b2 + kstep;
            PG8_LDB(B0, 0, 0); PG8_LDB(B1, 0, 1); PG8_SCHED; PG8_LDA(At, 0, 0); PG8_STAGE(PG8_SA(1, 1), a1 + hA, voffA);
            PG8_WAIT_V(8); PG8_WAIT_L(0); PG8_BAR; PG8_MMA(0, 0, At, B0); PG8_MMA(0, 1, At, B1); PG8_BAR; PG8_SCHED;
            PG8_LDA(At, 0, 1); PG8_STAGE(PG8_SB(0, 0), b2, voffB); PG8_STAGE(PG8_SB(0, 1), b2 + hB, voffB); PG8_STAGE(PG8_SA(0, 0), a2, voffA);
            PG8_WAIT_V(8); PG8_WAIT_L(0); PG8_BAR; PG8_MMA(1, 0, At, B0); PG8_MMA(1, 1, At, B1); PG8_BAR; PG8_SCHED;
            PG8_LDB(B0, 1, 0); PG8_LDB(B1, 1, 1); PG8_SCHED; PG8_LDA(At, 1, 0); PG8_STAGE(PG8_SA(0, 1), a2 + hA, voffA);
            PG8_WAIT_V(8); PG8_WAIT_L(0); PG8_BAR; PG8_MMA(0, 0, At, B0); PG8_MMA(0, 1, At, B1); PG8_BAR; PG8_SCHED;
            PG8_LDA(At, 1, 1); PG8_STAGE(PG8_SB(1, 0), b3, voffB); PG8_STAGE(PG8_SB(1, 1), b3 + hB, voffB); PG8_STAGE(PG8_SA(1, 0), a3, voffA);
            PG8_WAIT_V(8); PG8_WAIT_L(0); PG8_BAR; PG8_MMA(1, 0, At, B0); PG8_MMA(1, 1, At, B1); PG8_BAR; PG8_SCHED;
        }
        if (wr == 0) PG8_BAR;
        E(acc, cur, wr, wc, fr, fq);
        if (!has_next) break;
#pragma unroll
        for (int a = 0; a < 2; ++a)
#pragma unroll
            for (int b = 0; b < 2; ++b)
#pragma unroll
                for (int m = 0; m < 4; ++m)
#pragma unroll
                    for (int n = 0; n < 2; ++n) acc[a][b][m][n] = (f32x4){0.f, 0.f, 0.f, 0.f};
        cur = nxt; cA = nA; cB = nB; ++ui;
        if (wr == 1) PG8_BAR;
    }
    PG8_WAIT_V(0);
    PG8_BAR;
#undef PG8_SA
#undef PG8_SB
#undef PG8_STAGE
#undef PG8_LDA
#undef PG8_LDB
#undef PG8_MMA
#undef PG8_WAIT_V
#undef PG8_WAIT_L
#undef PG8_BAR
#undef PG8_SCHED
}
}

#define XB_TMO      128
#define XB_XCNT(j)  (256  + 64 * (j))
#define XB_XSUB(j)  (1280 + 64 * (j))
#define XB_XGEN(j)  (2304 + 64 * (j))
#define XB_TOP      3328
#define XB_TOPGEN   3392
#define XCD_BAR_WORDS 3456
#define XB_SPIN_CAP (1u << 18)
__device__ __forceinline__ unsigned xb_ld(unsigned* p)              { return __hip_atomic_load(p, __ATOMIC_RELAXED, __HIP_MEMORY_SCOPE_AGENT); }
__device__ __forceinline__ unsigned xb_add(unsigned* p, unsigned v) { return __hip_atomic_fetch_add(p, v, __ATOMIC_RELAXED, __HIP_MEMORY_SCOPE_AGENT); }
__device__ __forceinline__ unsigned xb_xcc_id() { return (unsigned)__builtin_amdgcn_s_getreg((3 << 11) | 20) & 0xFu; }
#define XB_SPIN(cond, bar) do { unsigned _sp = 0; while (cond) { __builtin_amdgcn_s_sleep(1); \
    if ((++_sp & 255u) == 0u) { if (xb_ld(&(bar)[XB_TMO])) break; if (_sp > XB_SPIN_CAP) { atomicAdd(&(bar)[XB_TMO], 1u); break; } } } } while (0)
struct XcdBarrier { unsigned* bar; unsigned x; volatile LAS unsigned* st; };
__device__ __forceinline__ XcdBarrier xcd_barrier_post(unsigned* bar, volatile LAS unsigned* st) {
    XcdBarrier b; b.bar = bar; b.x = xb_xcc_id(); b.st = st;
    if (threadIdx.x == 0) (void)xb_add(&bar[XB_XCNT(b.x)], 1u);
    return b;
}
__device__ __forceinline__ void xcd_barrier_complete(unsigned* bar, unsigned x, unsigned& nloc, unsigned& nx) {
    const unsigned G = gridDim.x * gridDim.y * gridDim.z;
    unsigned sum, cnt, mine, sp = 0u;
    for (;;) {
        sum = 0u; cnt = 0u; mine = 0u;
#pragma unroll
        for (unsigned j = 0; j < 16; ++j) { const unsigned c = xb_ld(&bar[XB_XCNT(j)]); sum += c; cnt += (c > 0u) ? 1u : 0u; mine = (j == x) ? c : mine; }
        if (sum == G) break;
        __builtin_amdgcn_s_sleep(1);
        if ((++sp & 255u) == 0u) { if (xb_ld(&bar[XB_TMO])) break; if (sp > XB_SPIN_CAP) { atomicAdd(&bar[XB_TMO], 1u); break; } }
    }
    nloc = mine > 0u ? mine : 1u; nx = cnt > 0u ? cnt : 1u;
}
__device__ __forceinline__ void xcd_barrier(const XcdBarrier& b) {
    asm volatile("s_waitcnt vmcnt(0)" ::: "memory");
    __syncthreads();
    if (threadIdx.x == 0) {
        unsigned* bar = b.bar;
        __builtin_amdgcn_s_waitcnt(0);
        unsigned nloc = b.st[0], nx = b.st[1];
        if (nloc == 0u) { xcd_barrier_complete(bar, b.x, nloc, nx); b.st[0] = nloc; b.st[1] = nx; }
        const unsigned old = xb_add(&bar[XB_XSUB(b.x)], 1u);
        const unsigned gen = old / nloc;
        if (old + 1u == (gen + 1u) * nloc) {
            __builtin_amdgcn_fence(__ATOMIC_RELEASE, "agent");
            asm volatile("s_waitcnt vmcnt(0)" ::: "memory");
            const unsigned og = xb_add(&bar[XB_TOP], 1u);
            const unsigned tg = og / nx;
            if (og + 1u == (tg + 1u) * nx) xb_add(&bar[XB_TOPGEN], 1u);
            else XB_SPIN(xb_ld(&bar[XB_TOPGEN]) == tg, bar);
            __builtin_amdgcn_fence(__ATOMIC_ACQUIRE, "agent");
            xb_add(&bar[XB_XGEN(b.x)], 1u);
            asm volatile("s_waitcnt vmcnt(0)" ::: "memory");
        } else {
            XB_SPIN(xb_ld(&bar[XB_XGEN(b.x)]) == gen, bar);
            __builtin_amdgcn_fence(__ATOMIC_ACQUIRE, "agent");
            asm volatile("s_waitcnt vmcnt(0)" ::: "memory");
        }
    }
    __syncthreads();
}

struct Args { const float* in[N_IN]; float* out; unsigned char* ws; };
typedef const float* const __attribute__((address_space(4))) * in_table_t;
struct Frame {
    LAS unsigned char* lds;
    int tid, lane, wave, G, bid;
    float* out; unsigned char* ws; in_table_t in;
    __device__ __forceinline__ float* X() const { return out; }
    __device__ __forceinline__ bf16* XN() const { return (bf16*)(ws + WS_XN); }
    __device__ __forceinline__ bf16* ACT() const { return (bf16*)(ws + WS_ACT); }
    __device__ __forceinline__ bf16* Z() const { return (bf16*)(ws + WS_Z); }
    __device__ __forceinline__ bf16* OP() const { return (bf16*)(ws + WS_OP); }
    __device__ __forceinline__ bf16* BR() const { return (bf16*)(ws + WS_BR); }
    __device__ __forceinline__ bf16* MG() const { return (bf16*)(ws + WS_MG); }
    __device__ __forceinline__ float* Fb() const { return (float*)(ws + WS_F); }
    __device__ __forceinline__ float* LSE() const { return (float*)(ws + WS_LSE); }
    __device__ __forceinline__ float* MG32() const { return (float*)(ws + WS_MG32); }
    __device__ __forceinline__ const float* inp(int i) const { return in[i]; }
};
__device__ __forceinline__ bf16* wptr(const Frame& F, int l, size_t off) { return (bf16*)(F.ws + WS_W + (size_t)l * W_LSTRIDE + off); }

__device__ __forceinline__ void tr_item(const float* W, int N, int k0, int n0, bf16* WT, size_t drow0, int ldk, int koff, LAS float* scr, int lane) {
#pragma unroll 8
    for (int i = 0; i < 32; ++i) { const int kk = 2 * i + (lane >> 5); scr[kk * 33 + (lane & 31)] = W[(size_t)(k0 + kk) * N + n0 + (lane & 31)]; }
    LDS_WAIT(); asm volatile("" ::: "memory");
    const int c = lane & 7;
#pragma unroll
    for (int j = 0; j < 4; ++j) { const int n = (lane >> 3) + 8 * j; const LAS float* s = scr + (8 * c) * 33 + n;
        v4u o; o.x = cvt_pk_bf16(s[0 * 33], s[1 * 33]); o.y = cvt_pk_bf16(s[2 * 33], s[3 * 33]); o.z = cvt_pk_bf16(s[4 * 33], s[5 * 33]); o.w = cvt_pk_bf16(s[6 * 33], s[7 * 33]);
        *(GAS v4u*)(WT + (drow0 + n) * (size_t)ldk + koff + k0 + 8 * c) = o; }
    LDS_WAIT(); asm volatile("" ::: "memory");
}
__device__ __forceinline__ void rms_row_to_bf16(const float* xrow, const float* g, bf16* orow, float* xcopy, int lane) {
    const f32x4* xr = (const f32x4*)xrow + lane;
    f32x4 v[4]; float s = 0.f;
#pragma unroll
    for (int j = 0; j < 4; ++j) { v[j] = xr[64 * j]; s += (v[j].x * v[j].x + v[j].y * v[j].y) + (v[j].z * v[j].z + v[j].w * v[j].w); }
    const float r = 1.0f / sqrtf(wave_sum(s) * (1.f / DM) + EPS);
#pragma unroll
    for (int j = 0; j < 4; ++j) {
        if (xcopy) ((f32x4*)xcopy + lane)[64 * j] = v[j];
        const f32x4 gg = ((const f32x4*)g + lane)[64 * j];
        v2u w; w.x = cvt_pk_bf16(v[j].x * r * gg.x, v[j].y * r * gg.y); w.y = cvt_pk_bf16(v[j].z * r * gg.z, v[j].w * r * gg.w);
        ((v2u*)orow + lane)[64 * j] = w;
    }
}
__device__ __forceinline__ void p0_prologue(const Frame& F) {
    LAS float* scr = (LAS float*)(F.lds + F.wave * 16384);
    const int gw = F.bid * NWAVES + F.wave, NGW = F.G * NWAVES;
    constexpr int PER_LAYER = 14848;
    for (int it = gw; it < 2 * PER_LAYER; it += NGW) {
        const int l = it / PER_LAYER; int r = it % PER_LAYER;
        const float* W; int K, N, ldk, koff = 0, mode = 0; size_t dst;
        if (r < 1408) { W = F.inp(I_F1G) + (size_t)l * DM * FF; K = DM; N = FF; ldk = DM; dst = W_GU1; mode = 1; }
        else if ((r -= 1408) < 1408) { W = F.inp(I_F1U) + (size_t)l * DM * FF; K = DM; N = FF; ldk = DM; dst = W_GU1; mode = 2; }
        else if ((r -= 1408) < 1408) { W = F.inp(I_F1D) + (size_t)l * FF * DM; K = FF; N = DM; ldk = FF; dst = W_D1; }
        else if ((r -= 1408) < 4992) { W = F.inp(I_WIN) + (size_t)l * DM * ZP; K = DM; N = ZP; ldk = DM; dst = W_IN; }
        else if ((r -= 4992) < 128) { W = F.inp(I_WOA) + (size_t)l * 256 * DM; K = 256; N = DM; ldk = BRP; koff = BR_A; dst = W_OUT; }
        else if ((r -= 128) < 256) { W = F.inp(I_WOB) + (size_t)l * 512 * DM; K = 512; N = DM; ldk = BRP; koff = BR_B; dst = W_OUT; }
        else if ((r -= 256) < 256) { W = F.inp(I_WOC) + (size_t)l * 512 * DM; K = 512; N = DM; ldk = BRP; koff = BR_C; dst = W_OUT; }
        else if ((r -= 256) < 256) { W = F.inp(I_WOD) + (size_t)l * 512 * DM; K = 512; N = DM; ldk = BRP; koff = BR_D; dst = W_OUT; }
        else if ((r -= 256) < 512) { W = F.inp(I_WO) + (size_t)l * DM * DM; K = DM; N = DM; ldk = DM; dst = W_O; }
        else if ((r -= 512) < 1408) { W = F.inp(I_F2G) + (size_t)l * DM * FF; K = DM; N = FF; ldk = DM; dst = W_GU2; mode = 1; }
        else if ((r -= 1408) < 1408) { W = F.inp(I_F2U) + (size_t)l * DM * FF; K = DM; N = FF; ldk = DM; dst = W_GU2; mode = 2; }
        else { r -= 1408; W = F.inp(I_F2D) + (size_t)l * FF * DM; K = FF; N = DM; ldk = FF; dst = W_D2; }
        (void)K;
        const int nblk = N / 32, kb = r / nblk, nb = r % nblk, k0 = 64 * kb, n0 = 32 * nb;
        const size_t drow0 = mode == 0 ? (size_t)n0 : (size_t)((n0 / 128) * 256 + (n0 % 128) + (mode == 2 ? 128 : 0));
        tr_item(W, N, k0, n0, wptr(F, l, dst), drow0, ldk, koff, scr, F.lane);
    }
    for (int m = gw; m < T; m += NGW) {
        const float* src = m < TP ? F.inp(I_XP) + (size_t)m * DM : F.inp(I_XS) + (size_t)(m - TP) * DM;
        rms_row_to_bf16(src, F.inp(I_F1PRE), F.XN() + (size_t)m * DM, F.X() + (size_t)m * DM, F.lane);
    }
}
__device__ __forceinline__ void norm_phase(const Frame& F, const float* gpost, float scale, const float* gpre) {
    const int gw = F.bid * NWAVES + F.wave, NGW = F.G * NWAVES;
    for (int m = gw; m < T; m += NGW) {
        const f32x4* fr = (const f32x4*)(F.Fb() + (size_t)m * DM) + F.lane; f32x4* xr = (f32x4*)(F.X() + (size_t)m * DM) + F.lane;
        f32x4 f[4], x[4]; float s = 0.f;
#pragma unroll
        for (int j = 0; j < 4; ++j) { f[j] = fr[64 * j]; x[j] = xr[64 * j]; s += (f[j].x * f[j].x + f[j].y * f[j].y) + (f[j].z * f[j].z + f[j].w * f[j].w); }
        const float r = scale / sqrtf(wave_sum(s) * (1.f / DM) + EPS); float s2 = 0.f;
#pragma unroll
        for (int j = 0; j < 4; ++j) { const f32x4 gg = ((const f32x4*)gpost + F.lane)[64 * j]; x[j] = x[j] + f[j] * gg * r; xr[64 * j] = x[j];
            s2 += (x[j].x * x[j].x + x[j].y * x[j].y) + (x[j].z * x[j].z + x[j].w * x[j].w); }
        if (gpre) {
            const float r2 = 1.0f / sqrtf(wave_sum(s2) * (1.f / DM) + EPS);
#pragma unroll
            for (int j = 0; j < 4; ++j) { const f32x4 gg = ((const f32x4*)gpre + F.lane)[64 * j];
                v2u w; w.x = cvt_pk_bf16(x[j].x * r2 * gg.x, x[j].y * r2 * gg.y); w.y = cvt_pk_bf16(x[j].z * r2 * gg.z, x[j].w * r2 * gg.w);
                ((v2u*)(F.XN() + (size_t)m * DM) + F.lane)[64 * j] = w; }
        }
    }
}

__device__ __forceinline__ float alibi_slope(int head) { return exp2f(-8.0f * (float)(head + 1) / 12.0f); }

constexpr int AT_STRIDE = 144, AT_VOFF = 256 * AT_STRIDE;
__device__ __forceinline__ void attn_prompt_unit(const Frame& F, int u) {
    const int g = u >> 9; int rem = u & 511; const int b = rem >> 7; rem &= 127; const int hh = rem >> 5; const int blk = rem & 31;
    const int dsh = 2 * g, d = 1 << dsh, nbs = 5 - dsh;
    const int r = blk >> nbs, jb = blk & ((1 << nbs) - 1);
    const int head = 4 * g + hh;
    const bf16* Zb = F.Z() + (size_t)(b * SEQ) * ZP;
    const int tid = F.tid, lane = F.lane, w = F.wave;
#pragma unroll
    for (int i = 0; i < 8; ++i) {
        const int it = tid + i * NTHR; const int which = it >> 11, kap = (it >> 3) & 255, ch = it & 7;
        const int ik = 128 * (jb - 1) + kap;
        v4u v = (v4u){0u, 0u, 0u, 0u};
        if (ik >= 0) v = *(const v4u*)(Zb + (size_t)(r + d * ik) * ZP + (which ? ZV : ZK) + head * 64 + ch * 8);
        *(LAS v4u*)(F.lds + which * AT_VOFF + kap * AT_STRIDE + ch * 16) = v;
    }
    __syncthreads();
    const int q = lane & 15, h = lane >> 4;
    const int tq = r + d * (128 * jb + 16 * w + q);
    const bf16* qp = Zb + (size_t)tq * ZP + ZQ + head * 64;
    bf16x8 qf[2];
    qf[0] = *(const bf16x8*)(qp + 8 * h); qf[1] = *(const bf16x8*)(qp + 32 + 8 * h);
    const int kt0 = w & ~1;
    f32x4 sc[10];
#pragma unroll
    for (int i = 0; i < 10; ++i) {
        f32x4 a = (f32x4){0.f, 0.f, 0.f, 0.f};
#pragma unroll
        for (int s = 0; s < 2; ++s) {
            const bf16x8 kf = *(const LAS bf16x8*)(F.lds + ((kt0 + i) * 16 + q) * AT_STRIDE + 64 * s + 16 * h);
            a = __builtin_amdgcn_mfma_f32_16x16x32_bf16(kf, qf[s], a, 0, 0, 0);
        }
        sc[i] = a;
    }
    const float c1 = 0.125f * LOG2E, c2 = alibi_slope(head) * (float)d * LOG2E;
    const int kq = 128 + 16 * w + q;
    float mx = -INFINITY;
#pragma unroll
    for (int i = 0; i < 10; ++i)
#pragma unroll
        for (int e = 0; e < 4; ++e) {
            const int kap = 16 * (kt0 + i) + 4 * h + e; const int rel = kq - kap;
            const bool valid = (rel >= 0) && (rel <= 128) && (jb > 0 || kap >= 128);
            const float v = valid ? sc[i][e] * c1 - c2 * (float)rel : -INFINITY;
            sc[i][e] = v; mx = fmaxf(mx, v);
        }
    mx = fmaxf(mx, __shfl_xor(mx, 16)); mx = fmaxf(mx, __shfl_xor(mx, 32));
    float sum = 0.f;
#pragma unroll
    for (int i = 0; i < 10; ++i)
#pragma unroll
        for (int e = 0; e < 4; ++e) { const float p = fexp2(sc[i][e] - mx); sc[i][e] = p; sum += p; }
    sum += __shfl_xor(sum, 16); sum += __shfl_xor(sum, 32);
    f32x4 o[4];
#pragma unroll
    for (int dt = 0; dt < 4; ++dt) o[dt] = (f32x4){0.f, 0.f, 0.f, 0.f};
    const LAS unsigned char* vb = F.lds + AT_VOFF + (16 * kt0 + 4 * h + (q >> 2)) * AT_STRIDE + (lane & 3) * 8;
#pragma unroll
    for (int ks = 0; ks < 5; ++ks) {
        v4u pw; pw.x = cvt_pk_bf16(sc[2 * ks][0], sc[2 * ks][1]); pw.y = cvt_pk_bf16(sc[2 * ks][2], sc[2 * ks][3]);
        pw.z = cvt_pk_bf16(sc[2 * ks + 1][0], sc[2 * ks + 1][1]); pw.w = cvt_pk_bf16(sc[2 * ks + 1][2], sc[2 * ks + 1][3]);
        const bf16x8 pf = __builtin_bit_cast(bf16x8, pw);
#pragma unroll
        for (int dt = 0; dt < 4; ++dt) {
            const s16x4 lo = __builtin_amdgcn_ds_read_tr16_b64_v4i16((LAS s16x4*)(vb + (32 * ks) * AT_STRIDE + dt * 32));
            const s16x4 hi = __builtin_amdgcn_ds_read_tr16_b64_v4i16((LAS s16x4*)(vb + (32 * ks + 16) * AT_STRIDE + dt * 32));
            const bf16x8 vf = (bf16x8){lo[0], lo[1], lo[2], lo[3], hi[0], hi[1], hi[2], hi[3]};
            o[dt] = __builtin_amdgcn_mfma_f32_16x16x32_bf16(vf, pf, o[dt], 0, 0, 0);
        }
    }
    const float inv = 1.0f / sum;
    const size_t orow = (size_t)(b * SEQ + tq);
#pragma unroll
    for (int dt = 0; dt < 4; ++dt) {
        v2u wv; wv.x = cvt_pk_bf16(o[dt][0] * inv, o[dt][1] * inv); wv.y = cvt_pk_bf16(o[dt][2] * inv, o[dt][3] * inv);
        *(v2u*)(F.OP() + orow * 768 + head * 64 + 16 * dt + 4 * h) = wv;
    }
    if (h == 0) F.LSE()[orow * 12 + head] = (mx + log2f(sum)) * LN2;
    __syncthreads();
}
__device__ __forceinline__ void attn_merge_phase(const Frame& F) {
    const int gt = F.bid * NTHR + F.tid, NGT = F.G * NTHR;
    for (int it = gt; it < TP * 32; it += NGT) {
        const int t = it >> 5, slot = (it >> 3) & 3, ch = it & 7;
        const float l0 = F.LSE()[(size_t)t * 12 + slot], l1 = F.LSE()[(size_t)t * 12 + 4 + slot], l2 = F.LSE()[(size_t)t * 12 + 8 + slot];
        const float mx = fmaxf(l0, fmaxf(l1, l2));
        float w0 = fexp2((l0 - mx) * LOG2E), w1 = fexp2((l1 - mx) * LOG2E), w2 = fexp2((l2 - mx) * LOG2E);
        const float inv = 1.0f / (w0 + w1 + w2); w0 *= inv; w1 *= inv; w2 *= inv;
        float a[8], b[8], c[8], o[8];
        unpack8(*(const v4u*)(F.OP() + (size_t)t * 768 + slot * 64 + ch * 8), a);
        unpack8(*(const v4u*)(F.OP() + (size_t)t * 768 + (4 + slot) * 64 + ch * 8), b);
        unpack8(*(const v4u*)(F.OP() + (size_t)t * 768 + (8 + slot) * 64 + ch * 8), c);
#pragma unroll
        for (int e = 0; e < 8; ++e) o[e] = w0 * a[e] + w1 * b[e] + w2 * c[e];
        *(v4u*)(F.BR() + (size_t)t * BRP + BR_A + slot * 64 + ch * 8) = pack8(o);
    }
}
__device__ __forceinline__ void attn_sample_phase(const Frame& F, int l) {
    const int gw = F.bid * NWAVES + F.wave, NGW = F.G * NWAVES;
    const int lane = F.lane, lg = lane >> 4, li = lane & 15;
    for (int task = gw; task < NSEQ * 4 * DSEQ; task += NGW) {
        const int n = task >> 5, slot = (task >> 3) & 3, t = task & 7;
        const size_t rowq = (size_t)(TP + n * DSEQ + t);
        float m = -INFINITY, ls = 0.f; float ac[4] = {0.f, 0.f, 0.f, 0.f};
#pragma unroll 1
        for (int g = 0; g < 3; ++g) {
            const int head = 4 * g + slot, dsh = 2 * g, d = 1 << dsh, lw = 128 << dsh;
            const float* cache = F.inp(I_C128 + g) + ((size_t)(l * NSEQ + n) * lw) * 512 + slot * 64 + 4 * li;
            const v2u qw = *(const v2u*)(F.Z() + rowq * ZP + ZQ + head * 64 + 4 * li);
            const float c1 = 0.125f * LOG2E, c2 = alibi_slope(head) * (float)d * LOG2E;
            const float q0 = bf_lo(qw.x) * c1, q1 = bf_hi(qw.x) * c1, q2 = bf_lo(qw.y) * c1, q3 = bf_hi(qw.y) * c1;
            const int jn = (t >> dsh) + 1;
            for (int j0 = 0; j0 < jn; j0 += 4) {
                const int j = j0 + lg;
                if (j < jn) {
                    const size_t rk = (size_t)(TP + n * DSEQ + t - d * j);
                    const v2u kw = *(const v2u*)(F.Z() + rk * ZP + ZK + head * 64 + 4 * li), vw = *(const v2u*)(F.Z() + rk * ZP + ZV + head * 64 + 4 * li);
                    float s = q0 * bf_lo(kw.x) + q1 * bf_hi(kw.x) + q2 * bf_lo(kw.y) + q3 * bf_hi(kw.y);
                    s += __shfl_xor(s, 1); s += __shfl_xor(s, 2); s += __shfl_xor(s, 4); s += __shfl_xor(s, 8);
                    s -= c2 * (float)j;
                    const float mn = fmaxf(m, s), f = fexp2(m - mn), p = fexp2(s - mn);
                    ls = ls * f + p; ac[0] = ac[0] * f + p * bf_lo(vw.x); ac[1] = ac[1] * f + p * bf_hi(vw.x); ac[2] = ac[2] * f + p * bf_lo(vw.y); ac[3] = ac[3] * f + p * bf_hi(vw.y); m = mn;
                }
            }
            for (int j0 = jn; j0 <= 128; j0 += 16) {
                f32x4 kv[4], vv[4];
#pragma unroll
                for (int b = 0; b < 4; ++b) { const int j = j0 + 4 * b + lg; const int idx = lw + t - d * (j <= 128 ? j : 128);
                    kv[b] = *(const f32x4*)(cache + (size_t)idx * 512); vv[b] = *(const f32x4*)(cache + (size_t)idx * 512 + 256); }
#pragma unroll
                for (int b = 0; b < 4; ++b) { const int j = j0 + 4 * b + lg;
                    float s = q0 * kv[b].x + q1 * kv[b].y + q2 * kv[b].z + q3 * kv[b].w;
                    s += __shfl_xor(s, 1); s += __shfl_xor(s, 2); s += __shfl_xor(s, 4); s += __shfl_xor(s, 8);
                    s -= c2 * (float)j;
                    if (j <= 128) {
                        const float mn = fmaxf(m, s), f = fexp2(m - mn), p = fexp2(s - mn);
                        ls = ls * f + p; ac[0] = ac[0] * f + p * vv[b].x; ac[1] = ac[1] * f + p * vv[b].y; ac[2] = ac[2] * f + p * vv[b].z; ac[3] = ac[3] * f + p * vv[b].w; m = mn;
                    }
                }
            }
        }
        float M = fmaxf(m, __shfl_xor(m, 16)); M = fmaxf(M, __shfl_xor(M, 32));
        const float f = fexp2(m - M); ls *= f;
#pragma unroll
        for (int e = 0; e < 4; ++e) { ac[e] *= f; ac[e] += __shfl_xor(ac[e], 16); ac[e] += __shfl_xor(ac[e], 32); }
        ls += __shfl_xor(ls, 16); ls += __shfl_xor(ls, 32);
        if (lg == 0) { const float inv = 1.0f / ls; v2u w; w.x = cvt_pk_bf16(ac[0] * inv, ac[1] * inv); w.y = cvt_pk_bf16(ac[2] * inv, ac[3] * inv);
            *(v2u*)(F.BR() + rowq * BRP + BR_A + slot * 64 + 4 * li) = w; }
    }
}
__device__ __forceinline__ void branch_b_phase(const Frame& F, int l) {
    const int gt = F.bid * NTHR + F.tid, NGT = F.G * NTHR;
    const float* cw = F.inp(I_CBW) + (size_t)l * 3 * 512;
    for (int it = gt; it < T * 64; it += NGT) {
        const int row = it >> 6, c = (it & 63) * 8;
        float zc[3][8];
        const bool smp = row >= TP; const int p = smp ? (row - TP) & 7 : row & (SEQ - 1); const int n = (row - TP) >> 3;
#pragma unroll
        for (int k = 0; k < 3; ++k) {
            const int pp = p - 2 + k;
            if (pp >= 0) { float a[8], bb[8]; unpack8(*(const v4u*)(F.Z() + (size_t)(row - 2 + k) * ZP + ZCG + c), a); unpack8(*(const v4u*)(F.Z() + (size_t)(row - 2 + k) * ZP + ZBI + c), bb);
#pragma unroll
                for (int e = 0; e < 8; ++e) zc[k][e] = a[e] * bb[e]; }
            else if (smp) { const float* st = F.inp(I_SB) + ((size_t)(l * NSEQ + n) * 2 + (pp + 2)) * 512 + c; const f32x4 s0 = *(const f32x4*)st, s1 = *(const f32x4*)(st + 4);
                zc[k][0] = s0.x; zc[k][1] = s0.y; zc[k][2] = s0.z; zc[k][3] = s0.w; zc[k][4] = s1.x; zc[k][5] = s1.y; zc[k][6] = s1.z; zc[k][7] = s1.w; }
            else {
#pragma unroll
                for (int e = 0; e < 8; ++e) zc[k][e] = 0.f; }
        }
        float bg[8], o[8]; unpack8(*(const v4u*)(F.Z() + (size_t)row * ZP + ZBG + c), bg);
#pragma unroll
        for (int e = 0; e < 8; ++e) o[e] = bg[e] * (cw[c + e] * zc[0][e] + cw[512 + c + e] * zc[1][e] + cw[1024 + c + e] * zc[2][e]);
        *(v4u*)(F.BR() + (size_t)row * BRP + BR_B + c) = pack8(o);
        float* dst = nullptr;
        if (!smp && p >= SEQ - 2) dst = F.out + O_CBP + ((size_t)(l * 4 + (row >> 12)) * 2 + (p - (SEQ - 2))) * 512 + c;
        if (smp && p >= DSEQ - 2) dst = F.out + O_CBS + ((size_t)(l * NSEQ + n) * 2 + (p - (DSEQ - 2))) * 512 + c;
        if (dst) { *(f32x4*)dst = (f32x4){zc[2][0], zc[2][1], zc[2][2], zc[2][3]}; *(f32x4*)(dst + 4) = (f32x4){zc[2][4], zc[2][5], zc[2][6], zc[2][7]}; }
    }
}
__device__ __forceinline__ void kv_out_phase(const Frame& F, int l) {
    const int gt = F.bid * NTHR + F.tid, NGT = F.G * NTHR;
    constexpr int NROW = 4 * 2048 + TS;
    for (int it = gt; it < NROW * 192; it += NGT) {
        const int ri = it / 192, k = it % 192; const int kv = k / 96, head = (k % 96) >> 3, ch = k & 7, g = head >> 2, hh = head & 3;
        int row; float* dst;
        if (ri < 4 * 2048) {
            const int b = ri >> 11, pos = 2048 + (ri & 2047), keep = 128 << (2 * g);
            if (pos < SEQ - keep) continue;
            row = b * SEQ + pos;
            const size_t base = g == 0 ? O_A128P : (g == 1 ? O_A512P : O_A2048P);
            dst = F.out + base + (((size_t)(l * 4 + b) * keep + (pos - (SEQ - keep))) * 2 + kv) * 256 + hh * 64 + ch * 8;
        } else {
            const int rs = ri - 4 * 2048; row = TP + rs;
            const size_t base = g == 0 ? O_A128S : (g == 1 ? O_A512S : O_A2048S);
            dst = F.out + base + (((size_t)l * TS + rs) * 2 + kv) * 256 + hh * 64 + ch * 8;
        }
        float v[8]; unpack8(*(const v4u*)(F.Z() + (size_t)row * ZP + (kv ? ZV : ZK) + head * 64 + ch * 8), v);
        *(f32x4*)dst = (f32x4){v[0], v[1], v[2], v[3]}; *(f32x4*)(dst + 4) = (f32x4){v[4], v[5], v[6], v[7]};
    }
}
constexpr int CT_STRIDE = 272, CT_PART = 512 * CT_STRIDE;
__device__ __forceinline__ void branch_c_unit(const Frame& F, int l, int uc) {
    const int t0 = uc * 128, tid = F.tid, lane = F.lane, w = F.wave;
    const int s = tid & 127, gq = tid >> 7;
    const bf16* gv = F.Z() + (size_t)(t0 + s) * ZP + ZGV + gq * 128;
    LAS float* part = (LAS float*)(F.lds + CT_PART);
    float sm = 0.f, sq = 0.f;
#pragma unroll 4
    for (int c = 0; c < 16; ++c) { float v[8]; unpack8(*(const v4u*)(gv + c * 8), v);
#pragma unroll
        for (int e = 0; e < 8; ++e) { sm += v[e]; sq += v[e] * v[e]; } }
    part[(gq * 128 + s) * 2] = sm; part[(gq * 128 + s) * 2 + 1] = sq;
    __syncthreads();
    float ts = 0.f, tq = 0.f;
#pragma unroll
    for (int k = 0; k < 4; ++k) { ts += part[(k * 128 + s) * 2]; tq += part[(k * 128 + s) * 2 + 1]; }
    const float mean = ts * (1.f / 512.f), var = fmaxf(tq * (1.f / 512.f) - mean * mean, 0.f), rstd = 1.0f / sqrtf(var + EPS);
    const float* lg = F.inp(I_GLG) + (size_t)l * 512 + gq * 128; const float* lb = F.inp(I_GLB) + (size_t)l * 512 + gq * 128;
#pragma unroll 2
    for (int c = 0; c < 16; ++c) { float v[8]; unpack8(*(const v4u*)(gv + c * 8), v);
#pragma unroll
        for (int e = 0; e < 8; e += 2) { const unsigned pk = cvt_pk_bf16((v[e] - mean) * rstd * lg[c * 8 + e] + lb[c * 8 + e], (v[e + 1] - mean) * rstd * lg[c * 8 + e + 1] + lb[c * 8 + e + 1]);
            *(LAS bf16*)(F.lds + (gq * 128 + c * 8 + e) * CT_STRIDE + s * 2) = (bf16)(pk & 0xffffu);
            *(LAS bf16*)(F.lds + (gq * 128 + c * 8 + e + 1) * CT_STRIDE + s * 2) = (bf16)(pk >> 16); } }
    __syncthreads();
    const int q = lane & 15, h = lane >> 4; const int tt = 16 * w + q;
    const int nks = (w >> 1) + 1;
#pragma unroll 1
    for (int gg = 0; gg < 4; ++gg) {
        f32x4 acc[8];
#pragma unroll
        for (int ct = 0; ct < 8; ++ct) acc[ct] = (f32x4){0.f, 0.f, 0.f, 0.f};
        const float* wsr = F.inp(I_GWS) + (((size_t)l * 4 + gg) * 128 + tt) * 128;
        for (int ks = 0; ks < nks; ++ks) {
            const int s0 = 32 * ks + 8 * h;
            const f32x4 w0 = *(const f32x4*)(wsr + s0), w1 = *(const f32x4*)(wsr + s0 + 4);
            float wv[8] = {w0.x, w0.y, w0.z, w0.w, w1.x, w1.y, w1.z, w1.w};
#pragma unroll
            for (int e = 0; e < 8; ++e) wv[e] = (s0 + e <= tt) ? wv[e] : 0.f;
            const bf16x8 wf = __builtin_bit_cast(bf16x8, pack8(wv));
#pragma unroll
            for (int ct = 0; ct < 8; ++ct) {
                const bf16x8 vf = *(const LAS bf16x8*)(F.lds + (gg * 128 + 16 * ct + q) * CT_STRIDE + s0 * 2);
                acc[ct] = __builtin_amdgcn_mfma_f32_16x16x32_bf16(vf, wf, acc[ct], 0, 0, 0);
            }
        }
        const float bias = F.inp(I_GB)[((size_t)l * 4 + gg) * 128 + tt];
        const size_t row = (size_t)(t0 + tt);
#pragma unroll
        for (int ct = 0; ct < 8; ++ct) {
            const int cc = gg * 128 + 16 * ct + 4 * h;
            const v2u uw = *(const v2u*)(F.Z() + row * ZP + ZU + cc);
            v2u ow; ow.x = cvt_pk_bf16(bf_lo(uw.x) * (acc[ct][0] + bias), bf_hi(uw.x) * (acc[ct][1] + bias)); ow.y = cvt_pk_bf16(bf_lo(uw.y) * (acc[ct][2] + bias), bf_hi(uw.y) * (acc[ct][3] + bias));
            *(v2u*)(F.BR() + row * BRP + BR_C + cc) = ow;
        }
    }
    __syncthreads();
}
__device__ __forceinline__ void branch_c_sample_phase(const Frame& F, int l) {
    const int gw = F.bid * NWAVES + F.wave, NGW = F.G * NWAVES, lane = F.lane;
    const float* lg = F.inp(I_GLG) + (size_t)l * 512 + lane * 8; const float* lb = F.inp(I_GLB) + (size_t)l * 512 + lane * 8;
    const int gg = lane >> 4;
    for (int n = gw; n < NSEQ; n += NGW) {
        float vn[8][8];
#pragma unroll
        for (int t = 0; t < 8; ++t) {
            const size_t row = (size_t)(TP + n * DSEQ + t);
            float v[8]; unpack8(*(const v4u*)(F.Z() + row * ZP + ZGV + lane * 8), v);
            float sm = 0.f;
#pragma unroll
            for (int e = 0; e < 8; ++e) sm += v[e];
            const float mean = wave_sum(sm) * (1.f / 512.f); float sq = 0.f;
#pragma unroll
            for (int e = 0; e < 8; ++e) { v[e] -= mean; sq += v[e] * v[e]; }
            const float rstd = 1.0f / sqrtf(wave_sum(sq) * (1.f / 512.f) + EPS);
#pragma unroll
            for (int e = 0; e < 8; ++e) vn[t][e] = v[e] * rstd * lg[e] + lb[e];
            float* dst = F.out + O_GVS + ((size_t)(l * NSEQ + n) * DSEQ + t) * 512 + lane * 8;
            *(f32x4*)dst = (f32x4){vn[t][0], vn[t][1], vn[t][2], vn[t][3]}; *(f32x4*)(dst + 4) = (f32x4){vn[t][4], vn[t][5], vn[t][6], vn[t][7]};
        }
#pragma unroll
        for (int t = 0; t < 8; ++t) {
            const size_t row = (size_t)(TP + n * DSEQ + t);
            const float* wsr = F.inp(I_GWS) + (((size_t)l * 4 + gg) * 128 + t) * 128;
            const float bias = F.inp(I_GB)[((size_t)l * 4 + gg) * 128 + t];
            float mix[8];
#pragma unroll
            for (int e = 0; e < 8; ++e) mix[e] = bias;
#pragma unroll
            for (int s = 0; s <= t; ++s) { const float wv = wsr[s];
#pragma unroll
                for (int e = 0; e < 8; ++e) mix[e] += wv * vn[s][e]; }
            float u[8]; unpack8(*(const v4u*)(F.Z() + row * ZP + ZU + lane * 8), u);
#pragma unroll
            for (int e = 0; e < 8; ++e) mix[e] *= u[e];
            *(v4u*)(F.BR() + row * BRP + BR_C + lane * 8) = pack8(mix);
        }
    }
}
constexpr int DG_ROWB = 1024, DG_DC = 96 * DG_ROWB;
__device__ __forceinline__ void branch_d_unit(const Frame& F, int l, int ud) {
    const bool smp = ud >= 256; const int tid = F.tid, lane = F.lane, w = F.wave;
    const int b = ud >> 6, t0 = (ud & 63) * 64;
    const int n0 = (ud - 256) * 2;
    const int nrows = smp ? 76 : 94;
    for (int it = tid; it < nrows * 64; it += NTHR) {
        const int i = it >> 6, c = (it & 63) * 8;
        float gl[8];
        bool have = true; const float* stp = nullptr; size_t zrow = 0; float* dst = nullptr;
        if (!smp) { const int pos = t0 - 30 + i; if (pos < 0) have = false; else { zrow = (size_t)(b * SEQ + pos);
                if (i >= 30 && pos >= SEQ - 30) dst = F.out + O_CDP + ((size_t)(l * 4 + b) * 30 + (pos - (SEQ - 30))) * 512 + c; } }
        else { const int sq = i / 38, ii = i % 38, n = n0 + sq;
            if (ii < 30) stp = F.inp(I_SD) + ((size_t)(l * NSEQ + n) * 30 + ii) * 512 + c; else zrow = (size_t)(TP + n * DSEQ + (ii - 30));
            if (ii >= 8) dst = F.out + O_CDS + ((size_t)(l * NSEQ + n) * 30 + (ii - 8)) * 512 + c; }
        if (!have) {
#pragma unroll
            for (int e = 0; e < 8; ++e) gl[e] = 0.f;
        } else if (stp) { const f32x4 s0 = *(const f32x4*)stp, s1 = *(const f32x4*)(stp + 4);
            gl[0] = s0.x; gl[1] = s0.y; gl[2] = s0.z; gl[3] = s0.w; gl[4] = s1.x; gl[5] = s1.y; gl[6] = s1.z; gl[7] = s1.w;
        } else { float a[8], gg[8]; unpack8(*(const v4u*)(F.Z() + zrow * ZP + ZGA + c), a); unpack8(*(const v4u*)(F.Z() + zrow * ZP + ZGG + c), gg);
#pragma unroll
            for (int e = 0; e < 8; ++e) gl[e] = a[e] * sigmoidf_(gg[e]); }
        if (dst) { *(f32x4*)dst = (f32x4){gl[0], gl[1], gl[2], gl[3]}; *(f32x4*)(dst + 4) = (f32x4){gl[4], gl[5], gl[6], gl[7]}; }
        *(LAS v4u*)(F.lds + i * DG_ROWB + c * 2) = pack8(gl);
    }
    __syncthreads();
    float wk[31];
#pragma unroll
    for (int k = 0; k < 31; ++k) wk[k] = F.inp(I_CDW)[((size_t)l * 31 + k) * 512 + tid];
    const float cb = F.inp(I_CDB)[(size_t)l * 512 + tid];
    const float* lng = F.inp(I_CDLG) + (size_t)l * 512 + lane * 8; const float* lnb = F.inp(I_CDLB) + (size_t)l * 512 + lane * 8;
    LAS float* DC = (LAS float*)(F.lds + DG_DC);
    const int nblk = smp ? 2 : 8;
#pragma unroll 1
    for (int tb = 0; tb < nblk; ++tb) {
        const int rbase = smp ? tb * 38 : tb * 8;
        float gw[38];
#pragma unroll
        for (int i = 0; i < 38; ++i) gw[i] = bf1(*(const LAS bf16*)(F.lds + (rbase + i) * DG_ROWB + tid * 2));
#pragma unroll
        for (int o = 0; o < 8; ++o) { float dc = cb;
#pragma unroll
            for (int k = 0; k < 31; ++k) dc += wk[k] * gw[o + k];
            DC[o * 512 + tid] = dc; }
        __syncthreads();
        {
            const f32x4 a0 = *(const LAS f32x4*)(DC + w * 512 + lane * 8), a1 = *(const LAS f32x4*)(DC + w * 512 + lane * 8 + 4);
            float v[8] = {a0.x, a0.y, a0.z, a0.w, a1.x, a1.y, a1.z, a1.w};
            float sm = 0.f;
#pragma unroll
            for (int e = 0; e < 8; ++e) sm += v[e];
            const float mean = wave_sum(sm) * (1.f / 512.f); float sq = 0.f;
#pragma unroll
            for (int e = 0; e < 8; ++e) { v[e] -= mean; sq += v[e] * v[e]; }
            const float rstd = 1.0f / sqrtf(wave_sum(sq) * (1.f / 512.f) + EPS);
#pragma unroll
            for (int e = 0; e < 8; ++e) { const float y = v[e] * rstd * lng[e] + lnb[e]; v[e] = y * sigmoidf_(y); }
            const size_t row = smp ? (size_t)(TP + (n0 + tb) * DSEQ + w) : (size_t)(b * SEQ + t0 + tb * 8 + w);
            *(v4u*)(F.BR() + row * BRP + BR_D + lane * 8) = pack8(v);
        }
        __syncthreads();
    }
}

__device__ __forceinline__ Frame make_frame(LAS unsigned char* lds, float* out, unsigned char* ws) {
    Frame F; F.lds = lds;
    int tid = threadIdx.x; asm volatile("" : "+v"(tid));
    F.tid = tid; F.lane = tid & 63; F.wave = __builtin_amdgcn_readfirstlane(tid >> 6);
    int G = gridDim.x, bid = blockIdx.x; asm volatile("" : "+s"(G), "+s"(bid));
    F.G = G; F.bid = bid;
    in_table_t in = (in_table_t)__builtin_amdgcn_kernarg_segment_ptr();
    asm volatile("" : "+s"(out), "+s"(ws), "+s"(in));
    F.out = out; F.ws = ws; F.in = in;
    return F;
}
template <int K> __device__ __forceinline__ void run_phase(LAS unsigned char* lds, float* out_, unsigned char* ws_, int l) {
    const Frame F = make_frame(lds, out_, ws_);
    if constexpr (K == 0) { p0_prologue(F); }
    if constexpr (K == 1) { pg8::Gemm<DM, DM, DM> g{F.XN(), wptr(F, l, W_GU1)}; pg8::StaticOrder<T, 2 * FF> S; S.init(F.G, F.bid); pg8::EpiSwiGLU E{F.ACT(), FF}; pg8::gemm_phase(F.lds, g, S, E, F.tid); }
    if constexpr (K == 2) { pg8::Gemm<FF, FF, FF> g{F.ACT(), wptr(F, l, W_D1)}; pg8::StaticOrder<T, DM> S; S.init(F.G, F.bid); pg8::EpiF32 E{F.Fb(), DM}; pg8::gemm_phase(F.lds, g, S, E, F.tid); }
    if constexpr (K == 3) { norm_phase(F, F.inp(I_F1POST) + l * DM, 0.5f, F.inp(I_MPRE) + l * DM); }
    if constexpr (K == 4) { pg8::Gemm<DM, DM, DM> g{F.XN(), wptr(F, l, W_IN)}; pg8::StaticOrder<T, ZP> S; S.init(F.G, F.bid); pg8::EpiZ E{F.Z(), ZP, ZGT / 256}; pg8::gemm_phase(F.lds, g, S, E, F.tid); }
    if constexpr (K == 5) {
        attn_sample_phase(F, l);
        { const Frame F2 = make_frame(lds, out_, ws_); for (int u = F2.bid; u < 1536; u += F2.G) attn_prompt_unit(F2, u); }
        { const Frame F2 = make_frame(lds, out_, ws_); for (int u = (F2.bid + 128) % F2.G; u < 128; u += F2.G) branch_c_unit(F2, l, u); }
        { const Frame F2 = make_frame(lds, out_, ws_); for (int u = F2.G - 1 - F2.bid; u < 256 + 64; u += F2.G) branch_d_unit(F2, l, u); }
        { const Frame F2 = make_frame(lds, out_, ws_); branch_c_sample_phase(F2, l); }
        { const Frame F2 = make_frame(lds, out_, ws_); branch_b_phase(F2, l); }
        { const Frame F2 = make_frame(lds, out_, ws_); kv_out_phase(F2, l); }
    }
    if constexpr (K == 6) { attn_merge_phase(F); }
    if constexpr (K == 7) {
        { pg8::StaticOrder<T, DM> S; S.init(F.G, F.bid); const bf16* wo = wptr(F, l, W_OUT);
          pg8::Gemm<256, BRP, BRP> g{F.BR() + BR_A, wo + BR_A}; pg8::EpiGate<0> E{F.MG32(), F.MG(), F.Z() + ZGT, ZP}; pg8::gemm_phase(F.lds, g, S, E, F.tid); }
        { const Frame F2 = make_frame(lds, out_, ws_); pg8::StaticOrder<T, DM> S; S.init(F2.G, F2.bid); const bf16* wo = wptr(F2, l, W_OUT);
          pg8::Gemm<512, BRP, BRP> g{F2.BR() + BR_B, wo + BR_B}; pg8::EpiGate<1> E{F2.MG32(), F2.MG(), F2.Z() + ZGT + 1024, ZP}; pg8::gemm_phase(F2.lds, g, S, E, F2.tid); }
        { const Frame F2 = make_frame(lds, out_, ws_); pg8::StaticOrder<T, DM> S; S.init(F2.G, F2.bid); const bf16* wo = wptr(F2, l, W_OUT);
          pg8::Gemm<512, BRP, BRP> g{F2.BR() + BR_C, wo + BR_C}; pg8::EpiGate<1> E{F2.MG32(), F2.MG(), F2.Z() + ZGT + 2048, ZP}; pg8::gemm_phase(F2.lds, g, S, E, F2.tid); }
        { const Frame F2 = make_frame(lds, out_, ws_); pg8::StaticOrder<T, DM> S; S.init(F2.G, F2.bid); const bf16* wo = wptr(F2, l, W_OUT);
          pg8::Gemm<512, BRP, BRP> g{F2.BR() + BR_D, wo + BR_D}; pg8::EpiGate<2> E{F2.MG32(), F2.MG(), F2.Z() + ZGT + 3072, ZP}; pg8::gemm_phase(F2.lds, g, S, E, F2.tid); }
    }
    if constexpr (K == 8) { pg8::Gemm<DM, DM, DM> g{F.MG(), wptr(F, l, W_O)}; pg8::StaticOrder<T, DM> S; S.init(F.G, F.bid); pg8::EpiF32 E{F.Fb(), DM}; pg8::gemm_phase(F.lds, g, S, E, F.tid); }
    if constexpr (K == 9) { norm_phase(F, F.inp(I_MPOST) + l * DM, 1.0f, F.inp(I_F2PRE) + l * DM); }
    if constexpr (K == 10) { pg8::Gemm<DM, DM, DM> g{F.XN(), wptr(F, l, W_GU2)}; pg8::StaticOrder<T, 2 * FF> S; S.init(F.G, F.bid); pg8::EpiSwiGLU E{F.ACT(), FF}; pg8::gemm_phase(F.lds, g, S, E, F.tid); }
    if constexpr (K == 11) { pg8::Gemm<FF, FF, FF> g{F.ACT(), wptr(F, l, W_D2)}; pg8::StaticOrder<T, DM> S; S.init(F.G, F.bid); pg8::EpiF32 E{F.Fb(), DM}; pg8::gemm_phase(F.lds, g, S, E, F.tid); }
    if constexpr (K == 12) { norm_phase(F, F.inp(I_F2POST) + l * DM, 0.5f, l == 0 ? F.inp(I_F1PRE) + DM : nullptr); }
}
#if MK_N_LAUNCHES == 1
__global__ void __launch_bounds__(NTHR, 2) fwd_kernel(Args args) {
    extern __shared__ __attribute__((aligned(16))) unsigned char lds_raw[];
    LAS unsigned char* const lds = (LAS unsigned char*)lds_raw;
    volatile LAS unsigned* MISC = (volatile LAS unsigned*)(lds + MISC_OFF);
    if (threadIdx.x < 64) MISC[threadIdx.x] = 0u;
    __syncthreads();
    XcdBarrier bar = xcd_barrier_post((unsigned*)(args.ws + WS_CTL) + CW_BAR, MISC + 8);
#define SEAM() do { XcdBarrier b2 = bar; asm volatile("" : "+s"(b2.bar)); xcd_barrier(b2); } while (0)
#define PH(K) run_phase<K>(lds, args.out, args.ws, l)
    { const int l = 0; PH(0); SEAM(); }
#ifndef MK_LAYER_LOOP
    { const int l = 0; PH(1); SEAM(); PH(2); SEAM(); PH(3); SEAM(); PH(4); SEAM(); PH(5); SEAM(); PH(6); SEAM();
        PH(7); SEAM(); PH(8); SEAM(); PH(9); SEAM(); PH(10); SEAM(); PH(11); SEAM(); PH(12); SEAM(); }
    { const int l = 1; PH(1); SEAM(); PH(2); SEAM(); PH(3); SEAM(); PH(4); SEAM(); PH(5); SEAM(); PH(6); SEAM();
        PH(7); SEAM(); PH(8); SEAM(); PH(9); SEAM(); PH(10); SEAM(); PH(11); SEAM(); PH(12); }
#else
    for (int l = 0; l < 2; ++l) {
        PH(1); SEAM(); PH(2); SEAM(); PH(3); SEAM(); PH(4); SEAM(); PH(5); SEAM(); PH(6); SEAM();
        PH(7); SEAM(); PH(8); SEAM(); PH(9); SEAM(); PH(10); SEAM(); PH(11); SEAM(); PH(12); SEAM();
    }
#endif
#undef SEAM
#undef PH
}
#else
template <int K> __global__ void __launch_bounds__(NTHR, 2) phase_kernel(Args args, int l) {
    extern __shared__ __attribute__((aligned(16))) unsigned char lds_raw[];
    run_phase<K>((LAS unsigned char*)lds_raw, args.out, args.ws, l);
}
#endif

#if MK_N_LAUNCHES == 1
#define MAIN_KERNEL fwd_kernel
#else
#define MAIN_KERNEL phase_kernel<4>
template <int K> static void launch_phase(int grid, hipStream_t stream, const Args& a, int l) {
    (void)hipFuncSetAttribute((const void*)phase_kernel<K>, hipFuncAttributeMaxDynamicSharedMemorySize, LDS_BYTES);
    hipLaunchKernelGGL(phase_kernel<K>, dim3(grid), dim3(NTHR), LDS_BYTES, stream, a, l);
}
#endif
extern "C" void kernel_launch(void* const* d_in, const int* in_sizes, int n_in, void* d_out, int out_size, void* d_ws, size_t ws_size, hipStream_t stream) {
    static int grid = 0;
    if (grid == 0) {
        if (n_in != N_IN || (size_t)out_size != O_END || ws_size < WS_END) { fprintf(stderr, "kernel_launch: unexpected shapes (n_in %d out %d ws %zu)\n", n_in, out_size, ws_size); grid = -1; return; }
        int dev = 0, cus = 0, per_cu = 0;
        if (hipGetDevice(&dev) != hipSuccess || hipDeviceGetAttribute(&cus, hipDeviceAttributeMultiprocessorCount, dev) != hipSuccess) { grid = -1; return; }
        if (hipFuncSetAttribute((const void*)MAIN_KERNEL, hipFuncAttributeMaxDynamicSharedMemorySize, LDS_BYTES) != hipSuccess) { fprintf(stderr, "kernel_launch: hipFuncSetAttribute failed\n"); grid = -1; return; }
        if (hipOccupancyMaxActiveBlocksPerMultiprocessor(&per_cu, (const void*)MAIN_KERNEL, NTHR, LDS_BYTES) != hipSuccess || per_cu < 1) { fprintf(stderr, "kernel_launch: occupancy query says %d\n", per_cu); }
        (void)hipGetLastError();
        grid = cus;
    }
    if (grid < 0) return;
    (void)hipMemsetAsync((char*)d_ws + WS_CTL, 0, CTL_ZERO_BYTES, stream);
    Args a{};
    for (int i = 0; i < N_IN; ++i) a.in[i] = (const float*)d_in[i];
    a.out = (float*)d_out; a.ws = (unsigned char*)d_ws;
#if MK_N_LAUNCHES == 1
    hipLaunchKernelGGL(fwd_kernel, dim3(grid), dim3(NTHR), LDS_BYTES, stream, a);
#else
    launch_phase<0>(grid, stream, a, 0);
    for (int l = 0; l < 2; ++l) {
        launch_phase<1>(grid, stream, a, l); launch_phase<2>(grid, stream, a, l); launch_phase<3>(grid, stream, a, l); launch_phase<4>(grid, stream, a, l);
        launch_phase<5>(grid, stream, a, l); launch_phase<6>(grid, stream, a, l); launch_phase<7>(grid, stream, a, l); launch_phase<8>(grid, stream, a, l);
        launch_phase<9>(grid, stream, a, l); launch_phase<10>(grid, stream, a, l); launch_phase<11>(grid, stream, a, l); launch_phase<12>(grid, stream, a, l);
    }
#endif
}
```

```cpp
#include <hip/hip_runtime.h>
#include <cstdio>
#include <cstdint>

#ifndef MK_N_LAUNCHES
#define MK_N_LAUNCHES 1
#endif

#define GAS __attribute__((address_space(1)))
#define LAS __attribute__((address_space(3)))
typedef unsigned short bf16;
typedef unsigned v4u __attribute__((ext_vector_type(4)));
typedef unsigned v2u __attribute__((ext_vector_type(2)));
typedef float f32x4 __attribute__((ext_vector_type(4)));
typedef float f32x2 __attribute__((ext_vector_type(2)));
typedef short bf16x8 __attribute__((ext_vector_type(8)));
typedef short s16x4 __attribute__((ext_vector_type(4)));
typedef GAS unsigned gu32;

constexpr int TP = 16384, TS = 1024, T = TP + TS, DM = 1024, FF = 2816, ZN = 9984, ZP = 5888, BRP = 1792, SEQ = 4096, NSEQ = 128, DSEQ = 8;
constexpr int ZQ = 0, ZK = 768, ZV = 1536, ZBG = 2304, ZCG = 2816, ZBI = 3328, ZU = 3840, ZGV = 4352, ZGA = 4864, ZGG = 5376, ZGT = 5888;
constexpr int BR_A = 0, BR_B = 256, BR_C = 768, BR_D = 1280;
constexpr float EPS = 1e-6f, LOG2E = 1.4426950408889634f, LN2 = 0.6931471805599453f;
constexpr size_t O_YP = 0, O_YS = 16777216, O_A128P = 17825792, O_A512P = 18350080, O_A2048P = 20447232, O_A128S = 28835840, O_A512S = 29884416,
                 O_A2048S = 30932992, O_CBP = 31981568, O_CBS = 31989760, O_GVS = 32251904, O_CDP = 33300480, O_CDS = 33423360, O_END = 37355520;
enum { I_XP = 0, I_XS, I_C128, I_C512, I_C2048, I_SB, I_SD, I_F1PRE, I_F1POST, I_F1G, I_F1U, I_F1D, I_MPRE, I_MPOST, I_WIN, I_WOA, I_CBW, I_WOB, I_GLG, I_GLB,
       I_GWS, I_GB, I_WOC, I_CDW, I_CDB, I_CDLG, I_CDLB, I_WOD, I_WO, I_F2PRE, I_F2POST, I_F2G, I_F2U, I_F2D, N_IN };
constexpr size_t MiB = 1u << 20;
constexpr size_t WS_CTL = 0, CTL_ZERO_BYTES = 1 * MiB;
constexpr size_t WS_W = 2 * MiB, W_LSTRIDE = 64 * MiB, W_GU1 = 0, W_D1 = 12 * MiB, W_IN = 18 * MiB, W_OUT = 38 * MiB, W_O = 42 * MiB, W_GU2 = 44 * MiB, W_D2 = 56 * MiB;
constexpr size_t WS_XN = 130 * MiB, WS_ACT = 164 * MiB, WS_F = 258 * MiB, WS_Z = 326 * MiB, WS_GM = 522 * MiB, WS_OP = 658 * MiB, WS_LSE = 682 * MiB, WS_BR = 683 * MiB,
                 WS_MG32 = 743 * MiB, WS_MG = 811 * MiB, WS_END = 845 * MiB;
constexpr int CW_TMO = 0, CW_BAR = 4096;
constexpr int LDS_BYTES = 147456, MISC_OFF = LDS_BYTES - 256;
constexpr int NWAVES = 8, NTHR = 512;
constexpr int NPHASE = 25;

#define LDS_WAIT() asm volatile("s_waitcnt lgkmcnt(0)" ::: "memory")
#define VM_WAIT() asm volatile("s_waitcnt vmcnt(0)" ::: "memory")
#define RLX_AGENT __ATOMIC_RELAXED, __HIP_MEMORY_SCOPE_AGENT
__device__ __forceinline__ unsigned cvt_pk_bf16(float lo, float hi) { unsigned r; asm volatile("v_cvt_pk_bf16_f32 %0, %1, %2" : "=v"(r) : "v"(lo), "v"(hi)); return r; }
__device__ __forceinline__ float bf_lo(unsigned w) { return __uint_as_float(w << 16); }
__device__ __forceinline__ float bf_hi(unsigned w) { return __uint_as_float(w & 0xffff0000u); }
__device__ __forceinline__ float bf1(bf16 h) { return __uint_as_float((unsigned)h << 16); }
__device__ __forceinline__ float fexp2(float x) { return __builtin_amdgcn_exp2f(x); }
__device__ __forceinline__ float frcp(float x) { return __builtin_amdgcn_rcpf(x); }
__device__ __forceinline__ float sigmoidf_(float x) { return frcp(1.0f + fexp2(-LOG2E * x)); }
__device__ __forceinline__ float wave_sum(float v) {
#pragma unroll
    for (int o = 1; o < 64; o <<= 1) v += __shfl_xor(v, o);
    return v;
}
__device__ __forceinline__ void unpack8(const v4u w, float (&f)[8]) {
    f[0] = bf_lo(w.x); f[1] = bf_hi(w.x); f[2] = bf_lo(w.y); f[3] = bf_hi(w.y); f[4] = bf_lo(w.z); f[5] = bf_hi(w.z); f[6] = bf_lo(w.w); f[7] = bf_hi(w.w);
}
__device__ __forceinline__ v4u pack8(const float (&f)[8]) { v4u w; w.x = cvt_pk_bf16(f[0], f[1]); w.y = cvt_pk_bf16(f[2], f[3]); w.z = cvt_pk_bf16(f[4], f[5]); w.w = cvt_pk_bf16(f[6], f[7]); return w; }

namespace pg8 {
typedef unsigned short bf16_t;
typedef unsigned u32x4 __attribute__((ext_vector_type(4)));
constexpr int BM = 256, BK = 64, HALF = 128, HTB = HALF * BK * 2, STAGE_BYTES = 8 * HTB, NXCD = 8, WGM = 8;
__host__ __device__ __forceinline__ int lds_byte(int r, int c) { const int st = (r >> 4) * 2 + (c >> 5), rr = r & 15, cc = c & 31, ob = rr * 64 + cc * 2; return st * 1024 + (ob ^ (((ob >> 9) & 1) << 5)); }
__host__ __device__ __forceinline__ void stage_rc(int b, int& R, int& C) { const int st = b / 1024, sb = b % 1024, swz = sb ^ (((sb >> 9) & 1) << 5); R = (st >> 1) * 16 + swz / 64; C = (st & 1) * 32 + (swz % 64) / 2; }
__host__ __device__ __forceinline__ int perm32(int rho) { const int n = rho >> 4, i = rho & 15; return 8 * (i >> 2) + 4 * n + (i & 3); }
struct Unit { int pm, pn; };
template <int K_, int LDA_, int LDB_> struct Gemm { const bf16_t* A; const bf16_t* Bt; static constexpr int K = K_, lda = LDA_, ldb = LDB_; };
template <int M_, int N_> struct StaticOrder {
    static constexpr int nM = M_ / BM, nN = N_ / BM, nwg = nM * nN; int G, c;
    __host__ __device__ void init(int G_, int c_) { G = G_; c = c_; }
    __host__ __device__ bool next(int i, Unit& u) const {
        const long L = (long)i * G + c; if (L >= nwg) return false;
        int wgid = (int)L; { const int q = nwg / NXCD, r = nwg % NXCD, xcd = wgid % NXCD, off = wgid / NXCD; wgid = (xcd < r ? xcd * (q + 1) : r * (q + 1) + (xcd - r) * q) + off; }
        const int nig = WGM * nN, gid = wgid / nig, fm = gid * WGM, gsz = (nM - fm) < WGM ? (nM - fm) : WGM;
        u.pm = fm + ((wgid % nig) % gsz); u.pn = (wgid % nig) / gsz; return true;
    }
};
struct EpiSwiGLU {
    static constexpr bool PERM = true;
    bf16_t* O; int ldc;
    __device__ __forceinline__ void operator()(const f32x4 (&acc)[2][2][4][2], const Unit& u, int wr, int wc, int fr, int fq) const {
        const int row0 = u.pm * BM + wr * 64 + fr, col0 = u.pn * HALF + wc * 32 + 8 * fq;
#pragma unroll
        for (int ai = 0; ai < 2; ++ai)
#pragma unroll
            for (int m = 0; m < 4; ++m) {
                float o[8];
#pragma unroll
                for (int n = 0; n < 2; ++n)
#pragma unroll
                    for (int e = 0; e < 4; ++e) { const float g = acc[ai][0][m][n][e], up = acc[ai][1][m][n][e]; o[4 * n + e] = g * up * frcp(1.0f + fexp2(-LOG2E * g)); }
                *(u32x4*)(O + (size_t)(row0 + ai * HALF + m * 16) * ldc + col0) = pack8(o);
            }
    }
};
struct EpiZ {
    static constexpr bool PERM = true;
    bf16_t* O; int ldc; int gate_from; bf16_t* GMb;
    __device__ __forceinline__ void operator()(const f32x4 (&acc)[2][2][4][2], const Unit& u, int wr, int wc, int fr, int fq) const {
        const int row0 = u.pm * BM + wr * 64 + fr;
        if (u.pn < gate_from) {
            const int col0 = u.pn * BM + wc * 32 + 8 * fq;
#pragma unroll
            for (int ai = 0; ai < 2; ++ai)
#pragma unroll
                for (int m = 0; m < 4; ++m)
#pragma unroll
                    for (int bj = 0; bj < 2; ++bj) {
                        float o[8];
#pragma unroll
                        for (int n = 0; n < 2; ++n)
#pragma unroll
                            for (int e = 0; e < 4; ++e) o[4 * n + e] = acc[ai][bj][m][n][e];
                        *(u32x4*)(O + (size_t)(row0 + ai * HALF + m * 16) * ldc + col0 + bj * HALF) = pack8(o);
                    }
        } else {
            const int col0 = (u.pn - gate_from) * 64 + wc * 16 + 4 * fq;
#pragma unroll
            for (int ai = 0; ai < 2; ++ai)
#pragma unroll
                for (int m = 0; m < 4; ++m) {
                    float r1[4], r2[4], r3[4], fin[4];
#pragma unroll
                    for (int e = 0; e < 4; ++e) {
                        const float e0 = fexp2(-LOG2E * fminf(fmaxf(acc[ai][0][m][0][e], -60.f), 60.f)), e1 = fexp2(-LOG2E * fminf(fmaxf(acc[ai][0][m][1][e], -60.f), 60.f));
                        const float e2 = fexp2(-LOG2E * fminf(fmaxf(acc[ai][1][m][0][e], -60.f), 60.f)), e3 = fexp2(-LOG2E * fminf(fmaxf(acc[ai][1][m][1][e], -60.f), 60.f));
                        const float s0 = frcp(1.0f + e0), s1 = frcp(1.0f + e1), s2 = frcp(1.0f + e2), s3 = frcp(1.0f + e3);
                        r1[e] = s0 * (1.0f + e1); r2[e] = s1 * (1.0f + e2); r3[e] = s2 * (1.0f + e3); fin[e] = s3;
                    }
                    const size_t off = (size_t)(row0 + ai * HALF + m * 16) * DM + col0;
                    v2u w; w.x = cvt_pk_bf16(r1[0], r1[1]); w.y = cvt_pk_bf16(r1[2], r1[3]); *(v2u*)(GMb + off) = w;
                    w.x = cvt_pk_bf16(r2[0], r2[1]); w.y = cvt_pk_bf16(r2[2], r2[3]); *(v2u*)(GMb + (size_t)T * DM + off) = w;
                    w.x = cvt_pk_bf16(r3[0], r3[1]); w.y = cvt_pk_bf16(r3[2], r3[3]); *(v2u*)(GMb + (size_t)2 * T * DM + off) = w;
                    w.x = cvt_pk_bf16(fin[0], fin[1]); w.y = cvt_pk_bf16(fin[2], fin[3]); *(v2u*)(GMb + (size_t)3 * T * DM + off) = w;
                }
        }
    }
};
struct EpiF32 {
    static constexpr bool PERM = false;
    float* O; int ldc;
    __device__ __forceinline__ void operator()(const f32x4 (&acc)[2][2][4][2], const Unit& u, int wr, int wc, int fr, int fq) const {
        const int row0 = u.pm * BM + wr * 64 + fr, col0 = u.pn * BM + wc * 32 + 4 * fq;
#pragma unroll
        for (int ai = 0; ai < 2; ++ai)
#pragma unroll
            for (int m = 0; m < 4; ++m)
#pragma unroll
                for (int bj = 0; bj < 2; ++bj)
#pragma unroll
                    for (int n = 0; n < 2; ++n) *(f32x4*)(O + (size_t)(row0 + ai * HALF + m * 16) * ldc + col0 + bj * HALF + n * 16) = acc[ai][bj][m][n];
    }
    __device__ __forceinline__ void strip(const f32x4 (&sacc)[2], const Unit& u, int wr, int wc, int fr, int fq) const {
        const size_t r = (size_t)(TP + u.pm * 16 + fr); const int c0 = u.pn * BM + wr * HALF + wc * 32 + 4 * fq;
#pragma unroll
        for (int n = 0; n < 2; ++n) *(f32x4*)(O + r * ldc + c0 + n * 16) = sacc[n];
    }
};
__device__ __forceinline__ void scale8(f32x4& a0, f32x4& a1, const u32x4 g) {
    a0[0] *= bf_lo(g.x); a0[1] *= bf_hi(g.x); a0[2] *= bf_lo(g.y); a0[3] *= bf_hi(g.y); a1[0] *= bf_lo(g.z); a1[1] *= bf_hi(g.z); a1[2] *= bf_lo(g.w); a1[3] *= bf_hi(g.w);
}
struct GateHook {
    static constexpr bool ACTIVE = true;
    const bf16_t* GMb;
    __device__ __forceinline__ bool fires(int t) const { return t == 4 || t == 12 || t == 20; }
    __device__ __forceinline__ void operator()(int t, f32x4 (&acc)[2][2][4][2], f32x4 (&sacc)[2], const Unit& u, int wr, int wc, int fr, int fq) const {
        const bf16_t* gm = GMb + (size_t)(t == 4 ? 0 : (t == 12 ? 1 : 2)) * T * DM;
        const int row0 = u.pm * BM + wr * 64 + fr, col0 = u.pn * BM + wc * 32 + 8 * fq;
#pragma unroll
        for (int ai = 0; ai < 2; ++ai)
#pragma unroll
            for (int m = 0; m < 4; ++m) {
#pragma unroll
                for (int bj = 0; bj < 2; ++bj) scale8(acc[ai][bj][m][0], acc[ai][bj][m][1], *(const u32x4*)(gm + (size_t)(row0 + ai * HALF + m * 16) * DM + col0 + bj * HALF));
                if (m & 1) asm volatile("" ::: "memory");
            }
        scale8(sacc[0], sacc[1], *(const u32x4*)(gm + (size_t)(TP + u.pm * 16 + fr) * DM + u.pn * BM + wr * HALF + wc * 32 + 8 * fq));
    }
};
struct EpiGateFinal {
    static constexpr bool PERM = true;
    bf16_t* O; const bf16_t* gm;
    __device__ __forceinline__ void operator()(const f32x4 (&acc)[2][2][4][2], const Unit& u, int wr, int wc, int fr, int fq) const {
        const int row0 = u.pm * BM + wr * 64 + fr, col0 = u.pn * BM + wc * 32 + 8 * fq;
#pragma unroll
        for (int ai = 0; ai < 2; ++ai)
#pragma unroll
            for (int m = 0; m < 4; ++m) {
#pragma unroll
                for (int bj = 0; bj < 2; ++bj) { const size_t off = (size_t)(row0 + ai * HALF + m * 16) * DM + col0 + bj * HALF;
                    f32x4 a0 = acc[ai][bj][m][0], a1 = acc[ai][bj][m][1]; scale8(a0, a1, *(const u32x4*)(gm + off));
                    float o[8] = {a0[0], a0[1], a0[2], a0[3], a1[0], a1[1], a1[2], a1[3]}; *(u32x4*)(O + off) = pack8(o); }
                if (m & 1) asm volatile("" ::: "memory");
            }
    }
    __device__ __forceinline__ void strip(const f32x4 (&sacc)[2], const Unit& u, int wr, int wc, int fr, int fq) const {
        const size_t off = (size_t)(TP + u.pm * 16 + fr) * DM + u.pn * BM + wr * HALF + wc * 32 + 8 * fq;
        f32x4 a0 = sacc[0], a1 = sacc[1]; scale8(a0, a1, *(const u32x4*)(gm + off));
        float o[8] = {a0[0], a0[1], a0[2], a0[3], a1[0], a1[1], a1[2], a1[3]}; *(u32x4*)(O + off) = pack8(o);
    }
};

constexpr int STRIP_OFF = 8 * HTB;
struct NoHook { static constexpr bool ACTIVE = false; __device__ __forceinline__ bool fires(int) const { return false; } template <class... X> __device__ __forceinline__ void operator()(X&&...) const {} };
template <bool STRIP, class Epi, class Sched, class GemmT, class Hook = NoHook>
__device__ __forceinline__ void gemm_phase(LAS unsigned char* lds, const GemmT g, const Sched& S, const Epi& E, int tid_in, const Hook& H = Hook()) {
    const int tid = tid_in, wid = __builtin_amdgcn_readfirstlane(tid >> 6), lane = tid & 63, wr = wid >> 2, wc = wid & 3, fr = lane & 15, fq = lane >> 4;
    constexpr int K = GemmT::K, nt = K / BK;
    unsigned voffA[2], voffB[2];
#pragma unroll
    for (int i = 0; i < 2; ++i) { int R, C; stage_rc(tid * 16 + i * 8192, R, C); const int Rb = Epi::PERM ? ((R & ~31) + perm32(R & 31)) : R;
        voffA[i] = (unsigned)(R * GemmT::lda + C) * 2u; voffB[i] = (unsigned)(Rb * GemmT::ldb + C) * 2u; }
    constexpr size_t kstep = (size_t)(BK * 2);
    constexpr size_t hA = (size_t)HALF * GemmT::lda * 2, hB = (size_t)HALF * GemmT::ldb * 2;
    constexpr size_t tA = 2 * hA, tB = 2 * hB, tS = (size_t)16 * GemmT::lda * 2;
    const unsigned ldsw = (unsigned)wid * 1024u;
    const int aoff = lds_byte(wr * 64 + fr, fq * 8), boff = lds_byte(wc * 32 + fr, fq * 8);
    unsigned voffS = 0; int soff = 0;
    if constexpr (STRIP) { const int p = 16 * wid + (lane & 15), row = p >> 3, c = (p & 7) ^ (row & 7); voffS = (unsigned)(row * GemmT::lda + c * 8) * 2u;
        soff = STRIP_OFF + (fr * 8 + (fq ^ (fr & 7))) * 16; }
    const char* const sBase = (const char*)g.A + (size_t)TP * GemmT::lda * 2;
#define PG8_SA(b, h) (((b) * 2 + (h)) * HTB)
#define PG8_SB(b, h) ((4 + (b) * 2 + (h)) * HTB)
#define PG8_STAGE(bufoff, gbase, voff) do { _Pragma("unroll") for (int _i = 0; _i < 2; ++_i) \
        __builtin_amdgcn_global_load_lds((const unsigned*)((const char*)(gbase) + (voff)[_i]), (LAS unsigned*)(lds + (bufoff) + ldsw + _i * 8192), 16, 0, 0); } while (0)
#define PG8_STAGE_S(b, gbase) do { if constexpr (STRIP) { if (lane < 16) \
        __builtin_amdgcn_global_load_lds((const unsigned*)((const char*)(gbase) + voffS), (LAS unsigned*)(lds + STRIP_OFF + (b) * 2048 + wid * 256), 16, 0, 0); } } while (0)
#define PG8_LDA(dst, b, h) do { _Pragma("unroll") for (int m = 0; m < 4; ++m) _Pragma("unroll") for (int k = 0; k < 2; ++k) dst[m][k] = *(const LAS bf16x8*)(lds + PG8_SA(b, h) + aoff + m * 2048 + k * 1024); } while (0)
#define PG8_LDB(dst, b, h) do { _Pragma("unroll") for (int n = 0; n < 2; ++n) _Pragma("unroll") for (int k = 0; k < 2; ++k) dst[n][k] = *(const LAS bf16x8*)(lds + PG8_SB(b, h) + boff + n * 2048 + k * 1024); } while (0)
#define PG8_LDS_(b) do { if constexpr (STRIP) { Sf[0] = *(const LAS bf16x8*)(lds + (b) * 2048 + soff); Sf[1] = *(const LAS bf16x8*)(lds + (b) * 2048 + (soff ^ 64)); } } while (0)
#define PG8_MMA(ai, bj, At, Bt) do { __builtin_amdgcn_s_setprio(1); _Pragma("unroll") for (int m = 0; m < 4; ++m) _Pragma("unroll") for (int n = 0; n < 2; ++n) _Pragma("unroll") for (int k = 0; k < 2; ++k) \
        acc[ai][bj][m][n] = __builtin_amdgcn_mfma_f32_16x16x32_bf16(Bt[n][k], At[m][k], acc[ai][bj][m][n], 0, 0, 0); __builtin_amdgcn_s_setprio(0); } while (0)
#define PG8_MMA2(m0, m1) do { __builtin_amdgcn_s_setprio(1); _Pragma("unroll") for (int m = m0; m < m1; ++m) _Pragma("unroll") for (int n = 0; n < 2; ++n) _Pragma("unroll") for (int k = 0; k < 2; ++k) { \
        acc[1][0][m][n] = __builtin_amdgcn_mfma_f32_16x16x32_bf16(B0[n][k], At[m][k], acc[1][0][m][n], 0, 0, 0); acc[1][1][m][n] = __builtin_amdgcn_mfma_f32_16x16x32_bf16(B1[n][k], At[m][k], acc[1][1][m][n], 0, 0, 0); } __builtin_amdgcn_s_setprio(0); } while (0)
#define PG8_SP2_MMA(b) do { if constexpr (STRIP) { PG8_MMA2(0, 2); PG8_SCHED; PG8_LDS_(b); PG8_SCHED; PG8_MMA2(2, 4); PG8_WAIT_L(0); PG8_MMA_S(); } else { PG8_MMA(1, 0, At, B0); PG8_MMA(1, 1, At, B1); } } while (0)
#define PG8_MMA_S() do { if constexpr (STRIP) { if (wr == 0) { _Pragma("unroll") for (int n = 0; n < 2; ++n) _Pragma("unroll") for (int k = 0; k < 2; ++k) sacc[n] = __builtin_amdgcn_mfma_f32_16x16x32_bf16(B0[n][k], Sf[k], sacc[n], 0, 0, 0); } \
        else { _Pragma("unroll") for (int n = 0; n < 2; ++n) _Pragma("unroll") for (int k = 0; k < 2; ++k) sacc[n] = __builtin_amdgcn_mfma_f32_16x16x32_bf16(B1[n][k], Sf[k], sacc[n], 0, 0, 0); } } } while (0)
#define PG8_WAIT_V(n) asm volatile("s_waitcnt vmcnt(" #n ")" ::: "memory")
#define PG8_WAIT_VL() do { if constexpr (STRIP) PG8_WAIT_V(9); else PG8_WAIT_V(8); } while (0)
#define PG8_WAIT_L(n) asm volatile("s_waitcnt lgkmcnt(" #n ")" ::: "memory")
#define PG8_BAR __builtin_amdgcn_s_barrier()
#define PG8_SCHED __builtin_amdgcn_sched_barrier(0)
    Unit cur, nxt; int ui = 0;
    if (!S.next(0, cur)) return;
    f32x4 acc[2][2][4][2]; f32x4 sacc[2];
#pragma unroll
    for (int a = 0; a < 2; ++a)
#pragma unroll
        for (int b = 0; b < 2; ++b)
#pragma unroll
            for (int m = 0; m < 4; ++m)
#pragma unroll
                for (int n = 0; n < 2; ++n) acc[a][b][m][n] = (f32x4){0.f, 0.f, 0.f, 0.f};
    sacc[0] = (f32x4){0.f, 0.f, 0.f, 0.f}; sacc[1] = (f32x4){0.f, 0.f, 0.f, 0.f};
    bf16x8 At[4][2], B0[2][2], B1[2][2], Sf[2];
    const char* cA = (const char*)g.A + (size_t)cur.pm * tA; const char* cB = (const char*)g.Bt + (size_t)cur.pn * tB; const char* cS = sBase + (size_t)cur.pm * tS;
    PG8_STAGE(PG8_SB(0, 0), cB, voffB); PG8_STAGE(PG8_SB(0, 1), cB + hB, voffB); PG8_STAGE(PG8_SA(0, 0), cA, voffA); PG8_STAGE(PG8_SA(0, 1), cA + hA, voffA); PG8_STAGE_S(0, cS);
    if (wr == 1) PG8_BAR;
    if constexpr (STRIP) PG8_WAIT_V(3); else PG8_WAIT_V(2);
    PG8_BAR;
    PG8_STAGE(PG8_SB(1, 0), cB + kstep, voffB); PG8_STAGE(PG8_SA(1, 0), cA + kstep, voffA); PG8_STAGE(PG8_SB(1, 1), cB + hB + kstep, voffB);
    PG8_WAIT_V(6); PG8_BAR;
    for (;;) {
        const bool has_next = S.next(ui + 1, nxt);
        const char* nA = has_next ? (const char*)g.A + (size_t)nxt.pm * tA : cA; const char* nB = has_next ? (const char*)g.Bt + (size_t)nxt.pn * tB : cB;
        const char* nS = has_next ? sBase + (size_t)nxt.pm * tS : cS;
        for (int t = 0; t < nt; t += 2) {
            if constexpr (Hook::ACTIVE) { if (H.fires(t)) { int fr2 = fr, fq2 = fq; asm volatile("" : "+v"(fr2), "+v"(fq2)); H(t, acc, sacc, cur, wr, wc, fr2, fq2); } }
            const bool last = (t == nt - 2);
            const char* a1 = cA + (size_t)(t + 1) * kstep; const char* s1 = cS + (size_t)(t + 1) * kstep;
            const char* a2 = last ? nA : cA + (size_t)(t + 2) * kstep; const char* b2 = last ? nB : cB + (size_t)(t + 2) * kstep; const char* s2 = last ? nS : cS + (size_t)(t + 2) * kstep;
            const char* a3 = a2 + kstep; const char* b3 = b2 + kstep;
            PG8_LDB(B0, 0, 0); PG8_LDB(B1, 0, 1); PG8_SCHED; PG8_LDA(At, 0, 0); PG8_STAGE(PG8_SA(1, 1), a1 + hA, voffA); PG8_STAGE_S(1, s1);
            PG8_WAIT_VL(); PG8_WAIT_L(0); PG8_BAR; PG8_MMA(0, 0, At, B0); PG8_MMA(0, 1, At, B1); PG8_BAR; PG8_SCHED;
            PG8_LDA(At, 0, 1); PG8_STAGE(PG8_SB(0, 0), b2, voffB); PG8_STAGE(PG8_SB(0, 1), b2 + hB, voffB); PG8_STAGE(PG8_SA(0, 0), a2, voffA);
            PG8_WAIT_VL(); PG8_WAIT_L(0); PG8_BAR; PG8_SP2_MMA(0); PG8_BAR; PG8_SCHED;
            PG8_LDB(B0, 1, 0); PG8_LDB(B1, 1, 1); PG8_SCHED; PG8_LDA(At, 1, 0); PG8_STAGE(PG8_SA(0, 1), a2 + hA, voffA); PG8_STAGE_S(0, s2);
            PG8_WAIT_VL(); PG8_WAIT_L(0); PG8_BAR; PG8_MMA(0, 0, At, B0); PG8_MMA(0, 1, At, B1); PG8_BAR; PG8_SCHED;
            PG8_LDA(At, 1, 1); PG8_STAGE(PG8_SB(1, 0), b3, voffB); PG8_STAGE(PG8_SB(1, 1), b3 + hB, voffB); PG8_STAGE(PG8_SA(1, 0), a3, voffA);
            PG8_WAIT_VL(); PG8_WAIT_L(0); PG8_BAR; PG8_SP2_MMA(1); PG8_BAR; PG8_SCHED;
        }
        if (wr == 0) PG8_BAR;
        { int fr2 = fr, fq2 = fq; asm volatile("" : "+v"(fr2), "+v"(fq2));
          E(acc, cur, wr, wc, fr2, fq2);
          if constexpr (STRIP) E.strip(sacc, cur, wr, wc, fr2, fq2); }
        if (!has_next) break;
#pragma unroll
        for (int a = 0; a < 2; ++a)
#pragma unroll
            for (int b = 0; b < 2; ++b)
#pragma unroll
                for (int m = 0; m < 4; ++m)
#pragma unroll
                    for (int n = 0; n < 2; ++n) acc[a][b][m][n] = (f32x4){0.f, 0.f, 0.f, 0.f};
        sacc[0] = (f32x4){0.f, 0.f, 0.f, 0.f}; sacc[1] = (f32x4){0.f, 0.f, 0.f, 0.f};
        cur = nxt; cA = nA; cB = nB; cS = nS; ++ui;
        if (wr == 1) PG8_BAR;
    }
    PG8_WAIT_V(0);
    PG8_BAR;
#undef PG8_SA
#undef PG8_SB
#undef PG8_STAGE
#undef PG8_STAGE_S
#undef PG8_LDA
#undef PG8_LDB
#undef PG8_LDS_
#undef PG8_MMA
#undef PG8_MMA_S
#undef PG8_MMA2
#undef PG8_SP2_MMA
#undef PG8_WAIT_V
#undef PG8_WAIT_VL
#undef PG8_WAIT_L
#undef PG8_BAR
#undef PG8_SCHED
}
}

#define XB_TMO      128
#define XB_XCNT(j)  (256  + 64 * (j))
#define XB_XSUB(j)  (1280 + 64 * (j))
#define XB_XGEN(j)  (2304 + 64 * (j))
#define XB_TOP      3328
#define XB_TOPGEN   3392
#define XCD_BAR_WORDS 3456
#define XB_SPIN_CAP (1u << 18)
__device__ __forceinline__ unsigned xb_ld(unsigned* p)              { return __hip_atomic_load(p, __ATOMIC_RELAXED, __HIP_MEMORY_SCOPE_AGENT); }
__device__ __forceinline__ unsigned xb_add(unsigned* p, unsigned v) { return __hip_atomic_fetch_add(p, v, __ATOMIC_RELAXED, __HIP_MEMORY_SCOPE_AGENT); }
__device__ __forceinline__ unsigned xb_xcc_id() { return (unsigned)__builtin_amdgcn_s_getreg((3 << 11) | 20) & 0xFu; }
#define XB_SPIN(cond, bar) do { unsigned _sp = 0; while (cond) { __builtin_amdgcn_s_sleep(1); \
    if ((++_sp & 255u) == 0u) { if (xb_ld(&(bar)[XB_TMO])) break; if (_sp > XB_SPIN_CAP) { atomicAdd(&(bar)[XB_TMO], 1u); break; } } } } while (0)
struct XcdBarrier { unsigned* bar; unsigned x; volatile LAS unsigned* st; };
__device__ __forceinline__ XcdBarrier xcd_barrier_post(unsigned* bar, volatile LAS unsigned* st) {
    XcdBarrier b; b.bar = bar; b.x = xb_xcc_id(); b.st = st;
    if (threadIdx.x == 0) (void)xb_add(&bar[XB_XCNT(b.x)], 1u);
    return b;
}
__device__ __forceinline__ void xcd_barrier_complete(unsigned* bar, unsigned x, unsigned& nloc, unsigned& nx) {
    const unsigned G = gridDim.x * gridDim.y * gridDim.z;
    unsigned sum, cnt, mine, sp = 0u;
    for (;;) {
        sum = 0u; cnt = 0u; mine = 0u;
#pragma unroll
        for (unsigned j = 0; j < 16; ++j) { const unsigned c = xb_ld(&bar[XB_XCNT(j)]); sum += c; cnt += (c > 0u) ? 1u : 0u; mine = (j == x) ? c : mine; }
        if (sum == G) break;
        __builtin_amdgcn_s_sleep(1);
        if ((++sp & 255u) == 0u) { if (xb_ld(&bar[XB_TMO])) break; if (sp > XB_SPIN_CAP) { atomicAdd(&bar[XB_TMO], 1u); break; } }
    }
    nloc = mine > 0u ? mine : 1u; nx = cnt > 0u ? cnt : 1u;
}
__device__ __forceinline__ void xcd_barrier(const XcdBarrier& b) {
    asm volatile("s_waitcnt vmcnt(0)" ::: "memory");
    __syncthreads();
    if (threadIdx.x == 0) {
        unsigned* bar = b.bar;
        __builtin_amdgcn_s_waitcnt(0);
        unsigned nloc = b.st[0], nx = b.st[1];
        if (nloc == 0u) { xcd_barrier_complete(bar, b.x, nloc, nx); b.st[0] = nloc; b.st[1] = nx; }
        const unsigned old = xb_add(&bar[XB_XSUB(b.x)], 1u);
        const unsigned gen = old / nloc;
        if (old + 1u == (gen + 1u) * nloc) {
            __builtin_amdgcn_fence(__ATOMIC_RELEASE, "agent");
            asm volatile("s_waitcnt vmcnt(0)" ::: "memory");
            const unsigned og = xb_add(&bar[XB_TOP], 1u);
            const unsigned tg = og / nx;
            if (og + 1u == (tg + 1u) * nx) xb_add(&bar[XB_TOPGEN], 1u);
            else XB_SPIN(xb_ld(&bar[XB_TOPGEN]) == tg, bar);
            __builtin_amdgcn_fence(__ATOMIC_ACQUIRE, "agent");
            xb_add(&bar[XB_XGEN(b.x)], 1u);
            asm volatile("s_waitcnt vmcnt(0)" ::: "memory");
        } else {
            XB_SPIN(xb_ld(&bar[XB_XGEN(b.x)]) == gen, bar);
            __builtin_amdgcn_fence(__ATOMIC_ACQUIRE, "agent");
            asm volatile("s_waitcnt vmcnt(0)" ::: "memory");
        }
    }
    __syncthreads();
}

struct Args { const float* in[N_IN]; float* out; unsigned char* ws; };
typedef const float* const __attribute__((address_space(4))) * in_table_t;
struct Frame {
    LAS unsigned char* lds;
    int tid, lane, wave, G, bid;
    float* out; unsigned char* ws; in_table_t in;
    __device__ __forceinline__ float* X() const { return out; }
    __device__ __forceinline__ bf16* XN() const { return (bf16*)(ws + WS_XN); }
    __device__ __forceinline__ bf16* ACT() const { return (bf16*)(ws + WS_ACT); }
    __device__ __forceinline__ bf16* Z() const { return (bf16*)(ws + WS_Z); }
    __device__ __forceinline__ bf16* OP() const { return (bf16*)(ws + WS_OP); }
    __device__ __forceinline__ bf16* BR() const { return (bf16*)(ws + WS_BR); }
    __device__ __forceinline__ bf16* MG() const { return (bf16*)(ws + WS_MG); }
    __device__ __forceinline__ float* Fb() const { return (float*)(ws + WS_F); }
    __device__ __forceinline__ float* LSE() const { return (float*)(ws + WS_LSE); }
    __device__ __forceinline__ bf16* GM() const { return (bf16*)(ws + WS_GM); }
    __device__ __forceinline__ const float* inp(int i) const { return in[i]; }
};
__device__ __forceinline__ bf16* wptr(const Frame& F, int l, size_t off) { return (bf16*)(F.ws + WS_W + (size_t)l * W_LSTRIDE + off); }

__device__ __forceinline__ int wt_row(int mode, int s) {
    if (mode == 1) return (s >> 7) * 256 + (s & 127);
    if (mode == 2) return (s >> 7) * 256 + 128 + (s & 127);
    if (mode == 3 && s >= ZGT) { const int i = (s - ZGT) >> 10, j = (s - ZGT) & 1023, q = j >> 6, wc = (j >> 4) & 3, fq = (j >> 2) & 3, e = j & 3;
        return ZGT + 256 * q + 128 * (i >> 1) + 32 * wc + 8 * fq + 4 * (i & 1) + e; }
    return s;
}
__device__ __forceinline__ void tr_item(const float* W, int N, int k0, int n0, bf16* WT, int mode, int ldk, int koff, LAS float* scr, int lane) {
#pragma unroll 8
    for (int i = 0; i < 32; ++i) { const int kk = 2 * i + (lane >> 5); scr[kk * 33 + (lane & 31)] = W[(size_t)(k0 + kk) * N + n0 + (lane & 31)]; }
    LDS_WAIT(); asm volatile("" ::: "memory");
    const int c = lane & 7;
#pragma unroll
    for (int j = 0; j < 4; ++j) { const int n = (lane >> 3) + 8 * j; const LAS float* s = scr + (8 * c) * 33 + n;
        v4u o; o.x = cvt_pk_bf16(s[0 * 33], s[1 * 33]); o.y = cvt_pk_bf16(s[2 * 33], s[3 * 33]); o.z = cvt_pk_bf16(s[4 * 33], s[5 * 33]); o.w = cvt_pk_bf16(s[6 * 33], s[7 * 33]);
        *(GAS v4u*)(WT + (size_t)wt_row(mode, n0 + n) * (size_t)ldk + koff + k0 + 8 * c) = o; }
    LDS_WAIT(); asm volatile("" ::: "memory");
}
__device__ __forceinline__ void rms_row_to_bf16(const float* xrow, const float* g, bf16* orow, float* xcopy, int lane) {
    const f32x4* xr = (const f32x4*)xrow + lane;
    f32x4 v[4]; float s = 0.f;
#pragma unroll
    for (int j = 0; j < 4; ++j) { v[j] = xr[64 * j]; s += (v[j].x * v[j].x + v[j].y * v[j].y) + (v[j].z * v[j].z + v[j].w * v[j].w); }
    const float r = 1.0f / sqrtf(wave_sum(s) * (1.f / DM) + EPS);
#pragma unroll
    for (int j = 0; j < 4; ++j) {
        if (xcopy) ((f32x4*)xcopy + lane)[64 * j] = v[j];
        const f32x4 gg = ((const f32x4*)g + lane)[64 * j];
        v2u w; w.x = cvt_pk_bf16(v[j].x * r * gg.x, v[j].y * r * gg.y); w.y = cvt_pk_bf16(v[j].z * r * gg.z, v[j].w * r * gg.w);
        ((v2u*)orow + lane)[64 * j] = w;
    }
}
__device__ __forceinline__ void p0_prologue(const Frame& F) {
    LAS float* scr = (LAS float*)(F.lds + F.wave * 16384);
    const int gw = F.bid * NWAVES + F.wave, NGW = F.G * NWAVES;
    constexpr int PER_LAYER = 14848;
    for (int it = gw; it < 2 * PER_LAYER; it += NGW) {
        const int l = it / PER_LAYER; int r = it % PER_LAYER;
        const float* W; int K, N, ldk, koff = 0, mode = 0; size_t dst;
        if (r < 1408) { W = F.inp(I_F1G) + (size_t)l * DM * FF; K = DM; N = FF; ldk = DM; dst = W_GU1; mode = 1; }
        else if ((r -= 1408) < 1408) { W = F.inp(I_F1U) + (size_t)l * DM * FF; K = DM; N = FF; ldk = DM; dst = W_GU1; mode = 2; }
        else if ((r -= 1408) < 1408) { W = F.inp(I_F1D) + (size_t)l * FF * DM; K = FF; N = DM; ldk = FF; dst = W_D1; }
        else if ((r -= 1408) < 4992) { W = F.inp(I_WIN) + (size_t)l * DM * ZN; K = DM; N = ZN; ldk = DM; dst = W_IN; mode = 3; }
        else if ((r -= 4992) < 128) { W = F.inp(I_WOA) + (size_t)l * 256 * DM; K = 256; N = DM; ldk = BRP; koff = BR_A; dst = W_OUT; }
        else if ((r -= 128) < 256) { W = F.inp(I_WOB) + (size_t)l * 512 * DM; K = 512; N = DM; ldk = BRP; koff = BR_B; dst = W_OUT; }
        else if ((r -= 256) < 256) { W = F.inp(I_WOC) + (size_t)l * 512 * DM; K = 512; N = DM; ldk = BRP; koff = BR_C; dst = W_OUT; }
        else if ((r -= 256) < 256) { W = F.inp(I_WOD) + (size_t)l * 512 * DM; K = 512; N = DM; ldk = BRP; koff = BR_D; dst = W_OUT; }
        else if ((r -= 256) < 512) { W = F.inp(I_WO) + (size_t)l * DM * DM; K = DM; N = DM; ldk = DM; dst = W_O; }
        else if ((r -= 512) < 1408) { W = F.inp(I_F2G) + (size_t)l * DM * FF; K = DM; N = FF; ldk = DM; dst = W_GU2; mode = 1; }
        else if ((r -= 1408) < 1408) { W = F.inp(I_F2U) + (size_t)l * DM * FF; K = DM; N = FF; ldk = DM; dst = W_GU2; mode = 2; }
        else { r -= 1408; W = F.inp(I_F2D) + (size_t)l * FF * DM; K = FF; N = DM; ldk = FF; dst = W_D2; }
        (void)K;
        const int nblk = N / 32, kb = r / nblk, nb = r % nblk, k0 = 64 * kb, n0 = 32 * nb;
        tr_item(W, N, k0, n0, wptr(F, l, dst), mode, ldk, koff, scr, F.lane);
    }
    for (int m = gw; m < T; m += NGW) {
        const float* src = m < TP ? F.inp(I_XP) + (size_t)m * DM : F.inp(I_XS) + (size_t)(m - TP) * DM;
        rms_row_to_bf16(src, F.inp(I_F1PRE), F.XN() + (size_t)m * DM, F.X() + (size_t)m * DM, F.lane);
    }
}
__device__ __forceinline__ void norm_phase(const Frame& F, const float* gpost, float scale, const float* gpre) {
    const int gw = F.bid * NWAVES + F.wave, NGW = F.G * NWAVES;
    for (int m = gw; m < T; m += NGW) {
        const f32x4* fr = (const f32x4*)(F.Fb() + (size_t)m * DM) + F.lane; f32x4* xr = (f32x4*)(F.X() + (size_t)m * DM) + F.lane;
        f32x4 f[4], x[4]; float s = 0.f;
#pragma unroll
        for (int j = 0; j < 4; ++j) { f[j] = fr[64 * j]; x[j] = xr[64 * j]; s += (f[j].x * f[j].x + f[j].y * f[j].y) + (f[j].z * f[j].z + f[j].w * f[j].w); }
        const float r = scale / sqrtf(wave_sum(s) * (1.f / DM) + EPS); float s2 = 0.f;
#pragma unroll
        for (int j = 0; j < 4; ++j) { const f32x4 gg = ((const f32x4*)gpost + F.lane)[64 * j]; x[j] = x[j] + f[j] * gg * r; xr[64 * j] = x[j];
            s2 += (x[j].x * x[j].x + x[j].y * x[j].y) + (x[j].z * x[j].z + x[j].w * x[j].w); }
        if (gpre) {
            const float r2 = 1.0f / sqrtf(wave_sum(s2) * (1.f / DM) + EPS);
#pragma unroll
            for (int j = 0; j < 4; ++j) { const f32x4 gg = ((const f32x4*)gpre + F.lane)[64 * j];
                v2u w; w.x = cvt_pk_bf16(x[j].x * r2 * gg.x, x[j].y * r2 * gg.y); w.y = cvt_pk_bf16(x[j].z * r2 * gg.z, x[j].w * r2 * gg.w);
                ((v2u*)(F.XN() + (size_t)m * DM) + F.lane)[64 * j] = w; }
        }
    }
}

__device__ __forceinline__ float alibi_slope(int head) { return exp2f(-8.0f * (float)(head + 1) / 12.0f); }

constexpr int AT_STRIDE = 144, AT_VOFF = 256 * AT_STRIDE;
__device__ __forceinline__ void attn_prompt_unit(const Frame& F, int u) {
    const int g = u >> 9; int rem = u & 511; const int b = rem >> 7; rem &= 127; const int hh = rem >> 5; const int blk = rem & 31;
    const int dsh = 2 * g, d = 1 << dsh, nbs = 5 - dsh;
    const int r = blk >> nbs, jb = blk & ((1 << nbs) - 1);
    const int head = 4 * g + hh;
    const bf16* Zb = F.Z() + (size_t)(b * SEQ) * ZP;
    const int tid = F.tid, lane = F.lane, w = F.wave;
#pragma unroll
    for (int i = 0; i < 8; ++i) {
        const int it = tid + i * NTHR; const int which = it >> 11, kap = (it >> 3) & 255, ch = it & 7;
        const int ik = 128 * (jb - 1) + kap;
        v4u v = (v4u){0u, 0u, 0u, 0u};
        if (ik >= 0) v = *(const v4u*)(Zb + (size_t)(r + d * ik) * ZP + (which ? ZV : ZK) + head * 64 + ch * 8);
        *(LAS v4u*)(F.lds + which * AT_VOFF + kap * AT_STRIDE + ch * 16) = v;
    }
    __syncthreads();
    const int q = lane & 15, h = lane >> 4;
    const int tq = r + d * (128 * jb + 16 * w + q);
    const bf16* qp = Zb + (size_t)tq * ZP + ZQ + head * 64;
    bf16x8 qf[2];
    qf[0] = *(const bf16x8*)(qp + 8 * h); qf[1] = *(const bf16x8*)(qp + 32 + 8 * h);
    const int kt0 = w & ~1;
    f32x4 sc[10];
#pragma unroll
    for (int i = 0; i < 10; ++i) {
        f32x4 a = (f32x4){0.f, 0.f, 0.f, 0.f};
#pragma unroll
        for (int s = 0; s < 2; ++s) {
            const bf16x8 kf = *(const LAS bf16x8*)(F.lds + ((kt0 + i) * 16 + q) * AT_STRIDE + 64 * s + 16 * h);
            a = __builtin_amdgcn_mfma_f32_16x16x32_bf16(kf, qf[s], a, 0, 0, 0);
        }
        sc[i] = a;
    }
    const float c1 = 0.125f * LOG2E, c2 = alibi_slope(head) * (float)d * LOG2E;
    const int kq = 128 + 16 * w + q; const int jb0 = jb == 0 ? -1 : 0;
    float mx = -INFINITY;
#pragma unroll
    for (int i = 0; i < 10; ++i)
#pragma unroll
        for (int e = 0; e < 4; ++e) {
            const int kap = 16 * (kt0 + i) + 4 * h + e; const int rel = kq - kap;
            const int bad = ((rel | (128 - rel)) >> 31) | (jb0 & ((kap - 128) >> 31));
            const float x = sc[i][e] * c1 - c2 * (float)rel;
            const float v = __uint_as_float((__float_as_uint(x) & ~(unsigned)bad) | (0xff800000u & (unsigned)bad));
            sc[i][e] = v; mx = fmaxf(mx, v);
        }
    mx = fmaxf(mx, __shfl_xor(mx, 16)); mx = fmaxf(mx, __shfl_xor(mx, 32));
    float sum = 0.f;
#pragma unroll
    for (int i = 0; i < 10; ++i)
#pragma unroll
        for (int e = 0; e < 4; ++e) { const float p = fexp2(sc[i][e] - mx); sc[i][e] = p; sum += p; }
    sum += __shfl_xor(sum, 16); sum += __shfl_xor(sum, 32);
    f32x4 o[4];
#pragma unroll
    for (int dt = 0; dt < 4; ++dt) o[dt] = (f32x4){0.f, 0.f, 0.f, 0.f};
    const LAS unsigned char* vb = F.lds + AT_VOFF + (16 * kt0 + 4 * h + (q >> 2)) * AT_STRIDE + (lane & 3) * 8;
#pragma unroll
    for (int ks = 0; ks < 5; ++ks) {
        v4u pw; pw.x = cvt_pk_bf16(sc[2 * ks][0], sc[2 * ks][1]); pw.y = cvt_pk_bf16(sc[2 * ks][2], sc[2 * ks][3]);
        pw.z = cvt_pk_bf16(sc[2 * ks + 1][0], sc[2 * ks + 1][1]); pw.w = cvt_pk_bf16(sc[2 * ks + 1][2], sc[2 * ks + 1][3]);
        const bf16x8 pf = __builtin_bit_cast(bf16x8, pw);
#pragma unroll
        for (int dt = 0; dt < 4; ++dt) {
            const s16x4 lo = __builtin_amdgcn_ds_read_tr16_b64_v4i16((LAS s16x4*)(vb + (32 * ks) * AT_STRIDE + dt * 32));
            const s16x4 hi = __builtin_amdgcn_ds_read_tr16_b64_v4i16((LAS s16x4*)(vb + (32 * ks + 16) * AT_STRIDE + dt * 32));
            const bf16x8 vf = (bf16x8){lo[0], lo[1], lo[2], lo[3], hi[0], hi[1], hi[2], hi[3]};
            o[dt] = __builtin_amdgcn_mfma_f32_16x16x32_bf16(vf, pf, o[dt], 0, 0, 0);
        }
    }
    const float inv = 1.0f / sum;
    const size_t orow = (size_t)(b * SEQ + tq);
#pragma unroll
    for (int dt = 0; dt < 4; ++dt) {
        v2u wv; wv.x = cvt_pk_bf16(o[dt][0] * inv, o[dt][1] * inv); wv.y = cvt_pk_bf16(o[dt][2] * inv, o[dt][3] * inv);
        *(v2u*)(F.OP() + orow * 768 + head * 64 + 16 * dt + 4 * h) = wv;
    }
    if (h == 0) F.LSE()[orow * 12 + head] = (mx + log2f(sum)) * LN2;
    __syncthreads();
}
__device__ __forceinline__ void attn_merge_phase(const Frame& F) {
    const int gt = F.bid * NTHR + F.tid, NGT = F.G * NTHR;
    for (int it = gt; it < TP * 32; it += NGT) {
        const int t = it >> 5, slot = (it >> 3) & 3, ch = it & 7;
        const float l0 = F.LSE()[(size_t)t * 12 + slot], l1 = F.LSE()[(size_t)t * 12 + 4 + slot], l2 = F.LSE()[(size_t)t * 12 + 8 + slot];
        const float mx = fmaxf(l0, fmaxf(l1, l2));
        float w0 = fexp2((l0 - mx) * LOG2E), w1 = fexp2((l1 - mx) * LOG2E), w2 = fexp2((l2 - mx) * LOG2E);
        const float inv = 1.0f / (w0 + w1 + w2); w0 *= inv; w1 *= inv; w2 *= inv;
        float a[8], b[8], c[8], o[8];
        unpack8(*(const v4u*)(F.OP() + (size_t)t * 768 + slot * 64 + ch * 8), a);
        unpack8(*(const v4u*)(F.OP() + (size_t)t * 768 + (4 + slot) * 64 + ch * 8), b);
        unpack8(*(const v4u*)(F.OP() + (size_t)t * 768 + (8 + slot) * 64 + ch * 8), c);
#pragma unroll
        for (int e = 0; e < 8; ++e) o[e] = w0 * a[e] + w1 * b[e] + w2 * c[e];
        *(v4u*)(F.BR() + (size_t)t * BRP + BR_A + slot * 64 + ch * 8) = pack8(o);
    }
}
__device__ __forceinline__ void attn_sample_phase(const Frame& F, int l) {
    const int gw = F.bid * NWAVES + F.wave, NGW = F.G * NWAVES;
    const int lane = F.lane, lg = lane >> 4, li = lane & 15;
    for (int task = gw; task < NSEQ * 4 * DSEQ; task += NGW) {
        const int n = task >> 5, slot = (task >> 3) & 3, t = task & 7;
        const size_t rowq = (size_t)(TP + n * DSEQ + t);
        float m = -INFINITY, ls = 0.f; float ac[4] = {0.f, 0.f, 0.f, 0.f};
#pragma unroll 1
        for (int g = 0; g < 3; ++g) {
            const int head = 4 * g + slot, dsh = 2 * g, d = 1 << dsh, lw = 128 << dsh;
            const float* cache = F.inp(I_C128 + g) + ((size_t)(l * NSEQ + n) * lw) * 512 + slot * 64 + 4 * li;
            const v2u qw = *(const v2u*)(F.Z() + rowq * ZP + ZQ + head * 64 + 4 * li);
            const float c1 = 0.125f * LOG2E, c2 = alibi_slope(head) * (float)d * LOG2E;
            const float q0 = bf_lo(qw.x) * c1, q1 = bf_hi(qw.x) * c1, q2 = bf_lo(qw.y) * c1, q3 = bf_hi(qw.y) * c1;
            const int jn = (t >> dsh) + 1;
            for (int j0 = 0; j0 < jn; j0 += 4) {
                const int j = j0 + lg;
                if (j < jn) {
                    const size_t rk = (size_t)(TP + n * DSEQ + t - d * j);
                    const v2u kw = *(const v2u*)(F.Z() + rk * ZP + ZK + head * 64 + 4 * li), vw = *(const v2u*)(F.Z() + rk * ZP + ZV + head * 64 + 4 * li);
                    float s = q0 * bf_lo(kw.x) + q1 * bf_hi(kw.x) + q2 * bf_lo(kw.y) + q3 * bf_hi(kw.y);
                    s += __shfl_xor(s, 1); s += __shfl_xor(s, 2); s += __shfl_xor(s, 4); s += __shfl_xor(s, 8);
                    s -= c2 * (float)j;
                    const float mn = fmaxf(m, s), f = fexp2(m - mn), p = fexp2(s - mn);
                    ls = ls * f + p; ac[0] = ac[0] * f + p * bf_lo(vw.x); ac[1] = ac[1] * f + p * bf_hi(vw.x); ac[2] = ac[2] * f + p * bf_lo(vw.y); ac[3] = ac[3] * f + p * bf_hi(vw.y); m = mn;
                }
            }
            for (int j0 = jn; j0 <= 128; j0 += 16) {
                f32x4 kv[4], vv[4];
#pragma unroll
                for (int b = 0; b < 4; ++b) { const int j = j0 + 4 * b + lg; const int idx = lw + t - d * (j <= 128 ? j : 128);
                    kv[b] = *(const f32x4*)(cache + (size_t)idx * 512); vv[b] = *(const f32x4*)(cache + (size_t)idx * 512 + 256); }
#pragma unroll
                for (int b = 0; b < 4; ++b) { const int j = j0 + 4 * b + lg;
                    float s = q0 * kv[b].x + q1 * kv[b].y + q2 * kv[b].z + q3 * kv[b].w;
                    s += __shfl_xor(s, 1); s += __shfl_xor(s, 2); s += __shfl_xor(s, 4); s += __shfl_xor(s, 8);
                    s -= c2 * (float)j;
                    if (j <= 128) {
                        const float mn = fmaxf(m, s), f = fexp2(m - mn), p = fexp2(s - mn);
                        ls = ls * f + p; ac[0] = ac[0] * f + p * vv[b].x; ac[1] = ac[1] * f + p * vv[b].y; ac[2] = ac[2] * f + p * vv[b].z; ac[3] = ac[3] * f + p * vv[b].w; m = mn;
                    }
                }
            }
        }
        float M = fmaxf(m, __shfl_xor(m, 16)); M = fmaxf(M, __shfl_xor(M, 32));
        const float f = fexp2(m - M); ls *= f;
#pragma unroll
        for (int e = 0; e < 4; ++e) { ac[e] *= f; ac[e] += __shfl_xor(ac[e], 16); ac[e] += __shfl_xor(ac[e], 32); }
        ls += __shfl_xor(ls, 16); ls += __shfl_xor(ls, 32);
        if (lg == 0) { const float inv = 1.0f / ls; v2u w; w.x = cvt_pk_bf16(ac[0] * inv, ac[1] * inv); w.y = cvt_pk_bf16(ac[2] * inv, ac[3] * inv);
            *(v2u*)(F.BR() + rowq * BRP + BR_A + slot * 64 + 4 * li) = w; }
    }
}
__device__ __forceinline__ void branch_b_phase(const Frame& F, int l) {
    const int gt = F.bid * NTHR + F.tid, NGT = F.G * NTHR;
    const float* cw = F.inp(I_CBW) + (size_t)l * 3 * 512;
    for (int it = gt; it < T * 64; it += NGT) {
        const int row = it >> 6, c = (it & 63) * 8;
        float zc[3][8];
        const bool smp = row >= TP; const int p = smp ? (row - TP) & 7 : row & (SEQ - 1); const int n = (row - TP) >> 3;
#pragma unroll
        for (int k = 0; k < 3; ++k) {
            const int pp = p - 2 + k;
            if (pp >= 0) { float a[8], bb[8]; unpack8(*(const v4u*)(F.Z() + (size_t)(row - 2 + k) * ZP + ZCG + c), a); unpack8(*(const v4u*)(F.Z() + (size_t)(row - 2 + k) * ZP + ZBI + c), bb);
#pragma unroll
                for (int e = 0; e < 8; ++e) zc[k][e] = a[e] * bb[e]; }
            else if (smp) { const float* st = F.inp(I_SB) + ((size_t)(l * NSEQ + n) * 2 + (pp + 2)) * 512 + c; const f32x4 s0 = *(const f32x4*)st, s1 = *(const f32x4*)(st + 4);
                zc[k][0] = s0.x; zc[k][1] = s0.y; zc[k][2] = s0.z; zc[k][3] = s0.w; zc[k][4] = s1.x; zc[k][5] = s1.y; zc[k][6] = s1.z; zc[k][7] = s1.w; }
            else {
#pragma unroll
                for (int e = 0; e < 8; ++e) zc[k][e] = 0.f; }
        }
        float bg[8], o[8]; unpack8(*(const v4u*)(F.Z() + (size_t)row * ZP + ZBG + c), bg);
#pragma unroll
        for (int e = 0; e < 8; ++e) o[e] = bg[e] * (cw[c + e] * zc[0][e] + cw[512 + c + e] * zc[1][e] + cw[1024 + c + e] * zc[2][e]);
        *(v4u*)(F.BR() + (size_t)row * BRP + BR_B + c) = pack8(o);
        float* dst = nullptr;
        if (!smp && p >= SEQ - 2) dst = F.out + O_CBP + ((size_t)(l * 4 + (row >> 12)) * 2 + (p - (SEQ - 2))) * 512 + c;
        if (smp && p >= DSEQ - 2) dst = F.out + O_CBS + ((size_t)(l * NSEQ + n) * 2 + (p - (DSEQ - 2))) * 512 + c;
        if (dst) { *(f32x4*)dst = (f32x4){zc[2][0], zc[2][1], zc[2][2], zc[2][3]}; *(f32x4*)(dst + 4) = (f32x4){zc[2][4], zc[2][5], zc[2][6], zc[2][7]}; }
    }
}
__device__ __forceinline__ void kv_out_phase(const Frame& F, int l) {
    const int gt = F.bid * NTHR + F.tid, NGT = F.G * NTHR;
    constexpr int NROW = 4 * 2048 + TS;
    for (int it = gt; it < NROW * 192; it += NGT) {
        const int ri = it / 192, k = it % 192; const int kv = k / 96, head = (k % 96) >> 3, ch = k & 7, g = head >> 2, hh = head & 3;
        int row; float* dst;
        if (ri < 4 * 2048) {
            const int b = ri >> 11, pos = 2048 + (ri & 2047), keep = 128 << (2 * g);
            if (pos < SEQ - keep) continue;
            row = b * SEQ + pos;
            const size_t base = g == 0 ? O_A128P : (g == 1 ? O_A512P : O_A2048P);
            dst = F.out + base + (((size_t)(l * 4 + b) * keep + (pos - (SEQ - keep))) * 2 + kv) * 256 + hh * 64 + ch * 8;
        } else {
            const int rs = ri - 4 * 2048; row = TP + rs;
            const size_t base = g == 0 ? O_A128S : (g == 1 ? O_A512S : O_A2048S);
            dst = F.out + base + (((size_t)l * TS + rs) * 2 + kv) * 256 + hh * 64 + ch * 8;
        }
        float v[8]; unpack8(*(const v4u*)(F.Z() + (size_t)row * ZP + (kv ? ZV : ZK) + head * 64 + ch * 8), v);
        *(f32x4*)dst = (f32x4){v[0], v[1], v[2], v[3]}; *(f32x4*)(dst + 4) = (f32x4){v[4], v[5], v[6], v[7]};
    }
}
constexpr int CT_STRIDE = 272, CT_PART = 512 * CT_STRIDE;
__device__ __forceinline__ void branch_c_unit(const Frame& F, int l, int uc) {
    const int t0 = uc * 128, tid = F.tid, lane = F.lane, w = F.wave;
    const int s = tid & 127, gq = tid >> 7;
    const bf16* gv = F.Z() + (size_t)(t0 + s) * ZP + ZGV + gq * 128;
    LAS float* part = (LAS float*)(F.lds + CT_PART);
    float sm = 0.f, sq = 0.f;
#pragma unroll 4
    for (int c = 0; c < 16; ++c) { float v[8]; unpack8(*(const v4u*)(gv + c * 8), v);
#pragma unroll
        for (int e = 0; e < 8; ++e) { sm += v[e]; sq += v[e] * v[e]; } }
    part[(gq * 128 + s) * 2] = sm; part[(gq * 128 + s) * 2 + 1] = sq;
    __syncthreads();
    float ts = 0.f, tq = 0.f;
#pragma unroll
    for (int k = 0; k < 4; ++k) { ts += part[(k * 128 + s) * 2]; tq += part[(k * 128 + s) * 2 + 1]; }
    const float mean = ts * (1.f / 512.f), var = fmaxf(tq * (1.f / 512.f) - mean * mean, 0.f), rstd = 1.0f / sqrtf(var + EPS);
    const float* lg = F.inp(I_GLG) + (size_t)l * 512 + gq * 128; const float* lb = F.inp(I_GLB) + (size_t)l * 512 + gq * 128;
#pragma unroll 2
    for (int c = 0; c < 16; ++c) { float v[8]; unpack8(*(const v4u*)(gv + c * 8), v);
#pragma unroll
        for (int e = 0; e < 8; e += 2) { const unsigned pk = cvt_pk_bf16((v[e] - mean) * rstd * lg[c * 8 + e] + lb[c * 8 + e], (v[e + 1] - mean) * rstd * lg[c * 8 + e + 1] + lb[c * 8 + e + 1]);
            *(LAS bf16*)(F.lds + (gq * 128 + c * 8 + e) * CT_STRIDE + s * 2) = (bf16)(pk & 0xffffu);
            *(LAS bf16*)(F.lds + (gq * 128 + c * 8 + e + 1) * CT_STRIDE + s * 2) = (bf16)(pk >> 16); } }
    __syncthreads();
    const int q = lane & 15, h = lane >> 4; const int tt = 16 * w + q;
    const int nks = (w >> 1) + 1;
#pragma unroll 1
    for (int gg = 0; gg < 4; ++gg) {
        f32x4 acc[8];
#pragma unroll
        for (int ct = 0; ct < 8; ++ct) acc[ct] = (f32x4){0.f, 0.f, 0.f, 0.f};
        const float* wsr = F.inp(I_GWS) + (((size_t)l * 4 + gg) * 128 + tt) * 128;
        for (int ks = 0; ks < nks; ++ks) {
            const int s0 = 32 * ks + 8 * h;
            const f32x4 w0 = *(const f32x4*)(wsr + s0), w1 = *(const f32x4*)(wsr + s0 + 4);
            float wv[8] = {w0.x, w0.y, w0.z, w0.w, w1.x, w1.y, w1.z, w1.w};
#pragma unroll
            for (int e = 0; e < 8; ++e) wv[e] = (s0 + e <= tt) ? wv[e] : 0.f;
            const bf16x8 wf = __builtin_bit_cast(bf16x8, pack8(wv));
#pragma unroll
            for (int ct = 0; ct < 8; ++ct) {
                const bf16x8 vf = *(const LAS bf16x8*)(F.lds + (gg * 128 + 16 * ct + q) * CT_STRIDE + s0 * 2);
                acc[ct] = __builtin_amdgcn_mfma_f32_16x16x32_bf16(vf, wf, acc[ct], 0, 0, 0);
            }
        }
        const float bias = F.inp(I_GB)[((size_t)l * 4 + gg) * 128 + tt];
        const size_t row = (size_t)(t0 + tt);
#pragma unroll
        for (int ct = 0; ct < 8; ++ct) {
            const int cc = gg * 128 + 16 * ct + 4 * h;
            const v2u uw = *(const v2u*)(F.Z() + row * ZP + ZU + cc);
            v2u ow; ow.x = cvt_pk_bf16(bf_lo(uw.x) * (acc[ct][0] + bias), bf_hi(uw.x) * (acc[ct][1] + bias)); ow.y = cvt_pk_bf16(bf_lo(uw.y) * (acc[ct][2] + bias), bf_hi(uw.y) * (acc[ct][3] + bias));
            *(v2u*)(F.BR() + row * BRP + BR_C + cc) = ow;
        }
    }
    __syncthreads();
}
__device__ __forceinline__ void branch_c_sample_phase(const Frame& F, int l) {
    const int gw = F.bid * NWAVES + F.wave, NGW = F.G * NWAVES, lane = F.lane;
    const float* lg = F.inp(I_GLG) + (size_t)l * 512 + lane * 8; const float* lb = F.inp(I_GLB) + (size_t)l * 512 + lane * 8;
    const int gg = lane >> 4;
    for (int n = gw; n < NSEQ; n += NGW) {
        float vn[8][8];
#pragma unroll
        for (int t = 0; t < 8; ++t) {
            const size_t row = (size_t)(TP + n * DSEQ + t);
            float v[8]; unpack8(*(const v4u*)(F.Z() + row * ZP + ZGV + lane * 8), v);
            float sm = 0.f;
#pragma unroll
            for (int e = 0; e < 8; ++e) sm += v[e];
            const float mean = wave_sum(sm) * (1.f / 512.f); float sq = 0.f;
#pragma unroll
            for (int e = 0; e < 8; ++e) { v[e] -= mean; sq += v[e] * v[e]; }
            const float rstd = 1.0f / sqrtf(wave_sum(sq) * (1.f / 512.f) + EPS);
#pragma unroll
            for (int e = 0; e < 8; ++e) vn[t][e] = v[e] * rstd * lg[e] + lb[e];
            float* dst = F.out + O_GVS + ((size_t)(l * NSEQ + n) * DSEQ + t) * 512 + lane * 8;
            *(f32x4*)dst = (f32x4){vn[t][0], vn[t][1], vn[t][2], vn[t][3]}; *(f32x4*)(dst + 4) = (f32x4){vn[t][4], vn[t][5], vn[t][6], vn[t][7]};
        }
#pragma unroll
        for (int t = 0; t < 8; ++t) {
            const size_t row = (size_t)(TP + n * DSEQ + t);
            const float* wsr = F.inp(I_GWS) + (((size_t)l * 4 + gg) * 128 + t) * 128;
            const float bias = F.inp(I_GB)[((size_t)l * 4 + gg) * 128 + t];
            float mix[8];
#pragma unroll
            for (int e = 0; e < 8; ++e) mix[e] = bias;
#pragma unroll
            for (int s = 0; s <= t; ++s) { const float wv = wsr[s];
#pragma unroll
                for (int e = 0; e < 8; ++e) mix[e] += wv * vn[s][e]; }
            float u[8]; unpack8(*(const v4u*)(F.Z() + row * ZP + ZU + lane * 8), u);
#pragma unroll
            for (int e = 0; e < 8; ++e) mix[e] *= u[e];
            *(v4u*)(F.BR() + row * BRP + BR_C + lane * 8) = pack8(mix);
        }
    }
}
constexpr int DG_ROWB = 1024, DG_DC = 96 * DG_ROWB;
__device__ __forceinline__ void branch_d_unit(const Frame& F, int l, int ud) {
    const bool smp = ud >= 256; const int tid = F.tid, lane = F.lane, w = F.wave;
    const int b = ud >> 6, t0 = (ud & 63) * 64;
    const int n0 = (ud - 256) * 2;
    const int nrows = smp ? 76 : 94;
    for (int it = tid; it < nrows * 64; it += NTHR) {
        const int i = it >> 6, c = (it & 63) * 8;
        float gl[8];
        bool have = true; const float* stp = nullptr; size_t zrow = 0; float* dst = nullptr;
        if (!smp) { const int pos = t0 - 30 + i; if (pos < 0) have = false; else { zrow = (size_t)(b * SEQ + pos);
                if (i >= 30 && pos >= SEQ - 30) dst = F.out + O_CDP + ((size_t)(l * 4 + b) * 30 + (pos - (SEQ - 30))) * 512 + c; } }
        else { const int sq = i / 38, ii = i % 38, n = n0 + sq;
            if (ii < 30) stp = F.inp(I_SD) + ((size_t)(l * NSEQ + n) * 30 + ii) * 512 + c; else zrow = (size_t)(TP + n * DSEQ + (ii - 30));
            if (ii >= 8) dst = F.out + O_CDS + ((size_t)(l * NSEQ + n) * 30 + (ii - 8)) * 512 + c; }
        if (!have) {
#pragma unroll
            for (int e = 0; e < 8; ++e) gl[e] = 0.f;
        } else if (stp) { const f32x4 s0 = *(const f32x4*)stp, s1 = *(const f32x4*)(stp + 4);
            gl[0] = s0.x; gl[1] = s0.y; gl[2] = s0.z; gl[3] = s0.w; gl[4] = s1.x; gl[5] = s1.y; gl[6] = s1.z; gl[7] = s1.w;
        } else { float a[8], gg[8]; unpack8(*(const v4u*)(F.Z() + zrow * ZP + ZGA + c), a); unpack8(*(const v4u*)(F.Z() + zrow * ZP + ZGG + c), gg);
#pragma unroll
            for (int e = 0; e < 8; ++e) gl[e] = a[e] * sigmoidf_(gg[e]); }
        if (dst) { *(f32x4*)dst = (f32x4){gl[0], gl[1], gl[2], gl[3]}; *(f32x4*)(dst + 4) = (f32x4){gl[4], gl[5], gl[6], gl[7]}; }
        *(LAS v4u*)(F.lds + i * DG_ROWB + c * 2) = pack8(gl);
    }
    __syncthreads();
    float wk[31];
#pragma unroll
    for (int k = 0; k < 31; ++k) wk[k] = F.inp(I_CDW)[((size_t)l * 31 + k) * 512 + tid];
    const float cb = F.inp(I_CDB)[(size_t)l * 512 + tid];
    const float* lng = F.inp(I_CDLG) + (size_t)l * 512 + lane * 8; const float* lnb = F.inp(I_CDLB) + (size_t)l * 512 + lane * 8;
    LAS float* DC = (LAS float*)(F.lds + DG_DC);
    const int nblk = smp ? 2 : 8;
#pragma unroll 1
    for (int tb = 0; tb < nblk; ++tb) {
        const int rbase = smp ? tb * 38 : tb * 8;
        float gw[38];
#pragma unroll
        for (int i = 0; i < 38; ++i) gw[i] = bf1(*(const LAS bf16*)(F.lds + (rbase + i) * DG_ROWB + tid * 2));
#pragma unroll
        for (int o = 0; o < 8; ++o) { float dc = cb;
#pragma unroll
            for (int k = 0; k < 31; ++k) dc += wk[k] * gw[o + k];
            DC[o * 512 + tid] = dc; }
        __syncthreads();
        {
            const f32x4 a0 = *(const LAS f32x4*)(DC + w * 512 + lane * 8), a1 = *(const LAS f32x4*)(DC + w * 512 + lane * 8 + 4);
            float v[8] = {a0.x, a0.y, a0.z, a0.w, a1.x, a1.y, a1.z, a1.w};
            float sm = 0.f;
#pragma unroll
            for (int e = 0; e < 8; ++e) sm += v[e];
            const float mean = wave_sum(sm) * (1.f / 512.f); float sq = 0.f;
#pragma unroll
            for (int e = 0; e < 8; ++e) { v[e] -= mean; sq += v[e] * v[e]; }
            const float rstd = 1.0f / sqrtf(wave_sum(sq) * (1.f / 512.f) + EPS);
#pragma unroll
            for (int e = 0; e < 8; ++e) { const float y = v[e] * rstd * lng[e] + lnb[e]; v[e] = y * sigmoidf_(y); }
            const size_t row = smp ? (size_t)(TP + (n0 + tb) * DSEQ + w) : (size_t)(b * SEQ + t0 + tb * 8 + w);
            *(v4u*)(F.BR() + row * BRP + BR_D + lane * 8) = pack8(v);
        }
        __syncthreads();
    }
}

__device__ __forceinline__ Frame make_frame(LAS unsigned char* lds, float* out, unsigned char* ws) {
    Frame F; F.lds = lds;
    int tid = threadIdx.x; asm volatile("" : "+v"(tid));
    F.tid = tid; F.lane = tid & 63; F.wave = __builtin_amdgcn_readfirstlane(tid >> 6);
    int G = gridDim.x, bid = blockIdx.x; asm volatile("" : "+s"(G), "+s"(bid));
    F.G = G; F.bid = bid;
    in_table_t in = (in_table_t)__builtin_amdgcn_kernarg_segment_ptr();
    asm volatile("" : "+s"(out), "+s"(ws), "+s"(in));
    F.out = out; F.ws = ws; F.in = in;
    return F;
}
template <int K> __device__ __forceinline__ void run_phase(LAS unsigned char* lds, float* out_, unsigned char* ws_, int l) {
    const Frame F = make_frame(lds, out_, ws_);
    if constexpr (K == 0) { p0_prologue(F); }
    if constexpr (K == 1) { pg8::Gemm<DM, DM, DM> g{F.XN(), wptr(F, l, W_GU1)}; pg8::StaticOrder<T, 2 * FF> S; S.init(F.G, F.bid); pg8::EpiSwiGLU E{F.ACT(), FF}; pg8::gemm_phase<false>(F.lds, g, S, E, F.tid); }
    if constexpr (K == 2) { pg8::Gemm<FF, FF, FF> g{F.ACT(), wptr(F, l, W_D1)}; pg8::StaticOrder<TP, DM> S; S.init(F.G, F.bid); pg8::EpiF32 E{F.Fb(), DM}; pg8::gemm_phase<true>(F.lds, g, S, E, F.tid); }
    if constexpr (K == 3) { norm_phase(F, F.inp(I_F1POST) + l * DM, 0.5f, F.inp(I_MPRE) + l * DM); }
    if constexpr (K == 4) { pg8::Gemm<DM, DM, DM> g{F.XN(), wptr(F, l, W_IN)}; pg8::StaticOrder<T, ZN> S; S.init(F.G, F.bid); pg8::EpiZ E{F.Z(), ZP, ZGT / 256, F.GM()}; pg8::gemm_phase<false>(F.lds, g, S, E, F.tid); }
    if constexpr (K == 5) {
        attn_sample_phase(F, l);
        { const Frame F2 = make_frame(lds, out_, ws_); for (int u = F2.bid; u < 1536; u += F2.G) attn_prompt_unit(F2, u); }
        { const Frame F2 = make_frame(lds, out_, ws_); for (int u = (F2.bid + 128) % F2.G; u < 128; u += F2.G) branch_c_unit(F2, l, u); }
        { const Frame F2 = make_frame(lds, out_, ws_); for (int u = F2.G - 1 - F2.bid; u < 256 + 64; u += F2.G) branch_d_unit(F2, l, u); }
        { const Frame F2 = make_frame(lds, out_, ws_); branch_c_sample_phase(F2, l); }
        { const Frame F2 = make_frame(lds, out_, ws_); branch_b_phase(F2, l); }
        { const Frame F2 = make_frame(lds, out_, ws_); kv_out_phase(F2, l); }
    }
    if constexpr (K == 6) { attn_merge_phase(F); }
    if constexpr (K == 7) { pg8::Gemm<BRP, BRP, BRP> g{F.BR(), wptr(F, l, W_OUT)}; pg8::StaticOrder<TP, DM> S; S.init(F.G, F.bid);
        pg8::EpiGateFinal E{F.MG(), F.GM() + (size_t)3 * T * DM}; pg8::GateHook H{F.GM()}; pg8::gemm_phase<true>(F.lds, g, S, E, F.tid, H); }
    if constexpr (K == 8) { pg8::Gemm<DM, DM, DM> g{F.MG(), wptr(F, l, W_O)}; pg8::StaticOrder<TP, DM> S; S.init(F.G, F.bid); pg8::EpiF32 E{F.Fb(), DM}; pg8::gemm_phase<true>(F.lds, g, S, E, F.tid); }
    if constexpr (K == 9) { norm_phase(F, F.inp(I_MPOST) + l * DM, 1.0f, F.inp(I_F2PRE) + l * DM); }
    if constexpr (K == 10) { pg8::Gemm<DM, DM, DM> g{F.XN(), wptr(F, l, W_GU2)}; pg8::StaticOrder<T, 2 * FF> S; S.init(F.G, F.bid); pg8::EpiSwiGLU E{F.ACT(), FF}; pg8::gemm_phase<false>(F.lds, g, S, E, F.tid); }
    if constexpr (K == 11) { pg8::Gemm<FF, FF, FF> g{F.ACT(), wptr(F, l, W_D2)}; pg8::StaticOrder<TP, DM> S; S.init(F.G, F.bid); pg8::EpiF32 E{F.Fb(), DM}; pg8::gemm_phase<true>(F.lds, g, S, E, F.tid); }
    if constexpr (K == 12) { norm_phase(F, F.inp(I_F2POST) + l * DM, 0.5f, l == 0 ? F.inp(I_F1PRE) + DM : nullptr); }
}
#if MK_N_LAUNCHES == 1
__global__ void __launch_bounds__(NTHR, 2) fwd_kernel(Args args) {
    extern __shared__ __attribute__((aligned(16))) unsigned char lds_raw[];
    LAS unsigned char* const lds = (LAS unsigned char*)lds_raw;
    volatile LAS unsigned* MISC = (volatile LAS unsigned*)(lds + MISC_OFF);
    if (threadIdx.x < 64) MISC[threadIdx.x] = 0u;
    __syncthreads();
    XcdBarrier bar = xcd_barrier_post((unsigned*)(args.ws + WS_CTL) + CW_BAR, MISC + 8);
#define SEAM() do { XcdBarrier b2 = bar; asm volatile("" : "+s"(b2.bar)); xcd_barrier(b2); } while (0)
#define PH(K) run_phase<K>(lds, args.out, args.ws, l)
    { const int l = 0; PH(0); SEAM(); }
#ifndef MK_LAYER_LOOP
    { const int l = 0; PH(1); SEAM(); PH(2); SEAM(); PH(3); SEAM(); PH(4); SEAM(); PH(5); SEAM(); PH(6); SEAM();
        PH(7); SEAM(); PH(8); SEAM(); PH(9); SEAM(); PH(10); SEAM(); PH(11); SEAM(); PH(12); SEAM(); }
    { const int l = 1; PH(1); SEAM(); PH(2); SEAM(); PH(3); SEAM(); PH(4); SEAM(); PH(5); SEAM(); PH(6); SEAM();
        PH(7); SEAM(); PH(8); SEAM(); PH(9); SEAM(); PH(10); SEAM(); PH(11); SEAM(); PH(12); }
#else
    for (int l = 0; l < 2; ++l) {
        PH(1); SEAM(); PH(2); SEAM(); PH(3); SEAM(); PH(4); SEAM(); PH(5); SEAM(); PH(6); SEAM();
        PH(7); SEAM(); PH(8); SEAM(); PH(9); SEAM(); PH(10); SEAM(); PH(11); SEAM(); PH(12); SEAM();
    }
#endif
#undef SEAM
#undef PH
}
#else
template <int K> __global__ void __launch_bounds__(NTHR, 2) phase_kernel(Args args, int l) {
    extern __shared__ __attribute__((aligned(16))) unsigned char lds_raw[];
    run_phase<K>((LAS unsigned char*)lds_raw, args.out, args.ws, l);
}
#endif

#if MK_N_LAUNCHES == 1
#define MAIN_KERNEL fwd_kernel
#else
#define MAIN_KERNEL phase_kernel<4>
template <int K> static void launch_phase(int grid, hipStream_t stream, const Args& a, int l) {
    (void)hipFuncSetAttribute((const void*)phase_kernel<K>, hipFuncAttributeMaxDynamicSharedMemorySize, LDS_BYTES);
    hipLaunchKernelGGL(phase_kernel<K>, dim3(grid), dim3(NTHR), LDS_BYTES, stream, a, l);
}
#endif
extern "C" void kernel_launch(void* const* d_in, const int* in_sizes, int n_in, void* d_out, int out_size, void* d_ws, size_t ws_size, hipStream_t stream) {
    static int grid = 0;
    if (grid == 0) {
        if (n_in != N_IN || (size_t)out_size != O_END || ws_size < WS_END) { fprintf(stderr, "kernel_launch: unexpected shapes (n_in %d out %d ws %zu)\n", n_in, out_size, ws_size); grid = -1; return; }
        int dev = 0, cus = 0, per_cu = 0;
        if (hipGetDevice(&dev) != hipSuccess || hipDeviceGetAttribute(&cus, hipDeviceAttributeMultiprocessorCount, dev) != hipSuccess) { grid = -1; return; }
        if (hipFuncSetAttribute((const void*)MAIN_KERNEL, hipFuncAttributeMaxDynamicSharedMemorySize, LDS_BYTES) != hipSuccess) { fprintf(stderr, "kernel_launch: hipFuncSetAttribute failed\n"); grid = -1; return; }
        if (hipOccupancyMaxActiveBlocksPerMultiprocessor(&per_cu, (const void*)MAIN_KERNEL, NTHR, LDS_BYTES) != hipSuccess || per_cu < 1) { fprintf(stderr, "kernel_launch: occupancy query says %d\n", per_cu); }
        (void)hipGetLastError();
        grid = cus;
    }
    if (grid < 0) return;
    (void)hipMemsetAsync((char*)d_ws + WS_CTL, 0, CTL_ZERO_BYTES, stream);
    Args a{};
    for (int i = 0; i < N_IN; ++i) a.in[i] = (const float*)d_in[i];
    a.out = (float*)d_out; a.ws = (unsigned char*)d_ws;
#if MK_N_LAUNCHES == 1
    hipLaunchKernelGGL(fwd_kernel, dim3(grid), dim3(NTHR), LDS_BYTES, stream, a);
#else
    launch_phase<0>(grid, stream, a, 0);
    for (int l = 0; l < 2; ++l) {
        launch_phase<1>(grid, stream, a, l); launch_phase<2>(grid, stream, a, l); launch_phase<3>(grid, stream, a, l); launch_phase<4>(grid, stream, a, l);
        launch_phase<5>(grid, stream, a, l); launch_phase<6>(grid, stream, a, l); launch_phase<7>(grid, stream, a, l); launch_phase<8>(grid, stream, a, l);
        launch_phase<9>(grid, stream, a, l); launch_phase<10>(grid, stream, a, l); launch_phase<11>(grid, stream, a, l); launch_phase<12>(grid, stream, a, l);
    }
#endif
}
```
